# Optimizing an MI355X kernel written in HIP

```python
import jax
import jax.numpy as jnp
from jax import lax
import numpy as np

D_MODEL = 1024
BATCH = 16
SEQ = 256
DEPTH = 1
DEC_BATCH = 8
DEC_SEQ = 1024
PAST_LEN = 256

GRID_W = 64
HEAD_DIM = 64
D_RWKV = D_MODEL // 2
H_RWKV = D_RWKV // HEAD_DIM
D_ATTN = D_MODEL - D_RWKV
H_Q = D_ATTN // HEAD_DIM
H_KV = 2
GQA_GROUP = H_Q // H_KV
D_KV = H_KV * HEAD_DIM
LORA_W = 64
LORA_A = 64
LORA_G = 128
N_DIR = 2
D_FF = 2816
CONV_W = 3
Q_BLOCK = 128
ROPE_THETA = 10000.0
RMS_EPS = 1e-6
GN_EPS = 64e-5
IN_WIDTHS = (D_RWKV, D_RWKV, D_RWKV, LORA_W, LORA_A, LORA_G, D_ATTN, D_KV, D_KV)
D_IN = 3 * D_RWKV + LORA_W + LORA_A + LORA_G + D_ATTN + 2 * D_KV

kernel_name = 'hybrid_rwkv7_gqa_dit_step'


def rms_norm(x, g):
    xf = x.astype(jnp.float32)
    y = xf * lax.rsqrt(jnp.mean(xf * xf, axis=-1, keepdims=True) + RMS_EPS)
    return (y * g.astype(jnp.float32)).astype(x.dtype)


def ada_ln(cvec, w_mod, b_mod):
    m = jax.nn.silu(cvec) @ w_mod + b_mod
    return [t[:, None, :] for t in jnp.split(m, 6, axis=-1)]


def modulate(h, shift, scale):
    return h * (1.0 + scale) + shift


def heads(t):
    return t.reshape(t.shape[0], t.shape[1], -1, HEAD_DIM)


def split_projection(h, w_in):
    bounds = [int(b) for b in np.cumsum(IN_WIDTHS)[:-1]]
    return jnp.split(h @ w_in, bounds, axis=-1)


def grid_rope(x):
    n_tok = x.shape[1]
    n_rows = n_tok // GRID_W
    row = jnp.repeat(jnp.arange(n_rows), GRID_W).astype(jnp.float32)
    col = jnp.tile(jnp.arange(GRID_W), n_rows).astype(jnp.float32)
    half = HEAD_DIM // 2
    quarter = half // 2
    inv_freq = ROPE_THETA ** (-jnp.arange(quarter, dtype=jnp.float32) / quarter)

    def rotate(xp, pos):
        ang = pos[:, None] * inv_freq[None, :]
        cos = jnp.cos(ang)[None, :, None, :]
        sin = jnp.sin(ang)[None, :, None, :]
        x1, x2 = xp[..., :quarter], xp[..., quarter:]
        return jnp.concatenate([x1 * cos - x2 * sin, x1 * sin + x2 * cos], axis=-1)

    xf = x.astype(jnp.float32)
    out = jnp.concatenate([rotate(xf[..., :half], row), rotate(xf[..., half:], col)], axis=-1)
    return out.astype(x.dtype)


def block_attention(q, k, v):
    b, lq = q.shape[0], q.shape[1]
    n_blk = lq // Q_BLOCK
    qb = q.reshape(b, n_blk, Q_BLOCK, H_KV, GQA_GROUP, HEAD_DIM).transpose(1, 0, 2, 3, 4, 5)
    kf = k.astype(jnp.float32)
    vf = v.astype(jnp.float32)
    scale = HEAD_DIM ** -0.5

    def one_block(q_blk):
        s = jnp.einsum('bqkgd,bskd->bkgqs', q_blk.astype(jnp.float32), kf) * scale
        p = jax.nn.softmax(s, axis=-1)
        return jnp.einsum('bkgqs,bskd->bqkgd', p, vf).astype(q.dtype)

    o = lax.map(one_block, qb)
    return o.transpose(1, 0, 2, 3, 4, 5).reshape(b, lq, H_Q * HEAD_DIM)


def wkv_scan(r, w, k, v, kk, a, s0, reverse):
    def step(s, inp):
        r_t, w_t, k_t, v_t, kk_t, a_t = inp
        sa = jnp.einsum('bhvk,bhk->bhv', s, -kk_t)
        s = (s * w_t[:, :, None, :]
             + sa[..., None] * (kk_t * a_t)[:, :, None, :]
             + v_t[..., None] * k_t[:, :, None, :])
        return s, jnp.einsum('bhvk,bhk->bhv', s, r_t)

    xs = tuple(jnp.moveaxis(t, 1, 0) for t in (r, w, k, v, kk, a))
    s_fin, ys = lax.scan(step, s0, xs, reverse=reverse)
    return jnp.moveaxis(ys, 0, 1), s_fin


def rwkv_mixer(r, k, v, xw, xa, xg, s0, lp):
    f32 = jnp.float32
    out_dtype = r.dtype
    r, k, v, xw, xa, xg = (t.astype(f32) for t in (r, k, v, xw, xa, xg))
    g = jax.nn.sigmoid(xg) @ lp['g_up'].astype(f32)
    kk = heads(k * lp['k_k'].astype(f32))
    kk = kk * lax.rsqrt(jnp.sum(kk * kk, axis=-1, keepdims=True) + 1e-12)
    tw = jnp.tanh(xw)
    rh, vh = heads(r), heads(v)
    r_k = lp['r_k'].astype(f32)
    y_sum = jnp.zeros_like(rh)
    bonus = jnp.zeros_like(rh)
    finals = []
    for d in range(N_DIR):
        logw = -jax.nn.softplus(-(lp['w0'][d].astype(f32) + tw @ lp['w_up'][d].astype(f32))) - 0.5
        decay = jnp.exp(-jnp.exp(logw))
        a = jax.nn.sigmoid(lp['a0'][d].astype(f32) + xa @ lp['a_up'][d].astype(f32))
        kd = heads(k * (1.0 + (a - 1.0) * lp['k_a'].astype(f32)))
        y_d, s_d = wkv_scan(rh, heads(decay), kd, vh, kk, heads(a),
                            s0[:, d].astype(f32), reverse=(d == 1))
        y_sum = y_sum + y_d
        bonus = bonus + jnp.sum(rh * kd * r_k, axis=-1, keepdims=True) * vh
        finals.append(s_d)
    mu = jnp.mean(y_sum, axis=-1, keepdims=True)
    var = jnp.mean(jnp.square(y_sum - mu), axis=-1, keepdims=True)
    yn = ((y_sum - mu) * lax.rsqrt(var + GN_EPS)).reshape(r.shape)
    yn = yn * lp['gn_w'].astype(f32) + lp['gn_b'].astype(f32)
    y = (yn + bonus.reshape(r.shape)) * g
    return y.astype(out_dtype), jnp.stack(finals, axis=1)


def conv_ffn(h, lp):
    u = h @ lp['ffn_up']
    n_tok = u.shape[1]
    pad = CONV_W // 2
    up = jnp.pad(u, ((0, 0), (pad, pad), (0, 0)))
    conv = lp['conv_b'] + up[:, 0:n_tok] * lp['conv_w'][0]
    for j in range(1, CONV_W):
        conv = conv + up[:, j:j + n_tok] * lp['conv_w'][j]
    gate, val = jnp.split(conv, 2, axis=-1)
    return (jax.nn.silu(gate) * val) @ lp['ffn_down']


def trunk_layer(x, mod, lp, ctx=None):
    shift1, scale1, gate1, shift2, scale2, gate2 = mod
    b = x.shape[0]
    h = modulate(rms_norm(x, lp['norm_mix_pre']), shift1, scale1)
    r, k, v, xw, xa, xg, q, ka, va = split_projection(h, lp['w_in'])
    q = rms_norm(heads(q), lp['q_norm'])
    ka = rms_norm(heads(ka), lp['k_norm'])
    va = heads(va)
    if ctx is None:
        s0 = jnp.zeros((b, N_DIR, H_RWKV, HEAD_DIM, HEAD_DIM), jnp.float32)
        y_attn = block_attention(q, ka, va)
    else:
        k_ctx, v_ctx, s0 = ctx
        k_all = jnp.concatenate([grid_rope(ka), k_ctx.astype(ka.dtype)], axis=1)
        v_all = jnp.concatenate([va, v_ctx.astype(va.dtype)], axis=1)
        y_attn = block_attention(grid_rope(q), k_all, v_all)
    y_rwkv, s_fin = rwkv_mixer(r, k, v, xw, xa, xg, s0, lp)
    mix = jnp.concatenate([y_rwkv, y_attn], axis=-1) @ lp['w_out']
    x = x + gate1 * rms_norm(mix, lp['norm_mix_post'])
    h2 = modulate(rms_norm(x, lp['norm_ffn_pre']), shift2, scale2)
    x = x + gate2 * rms_norm(conv_ffn(h2, lp), lp['norm_ffn_post'])
    return x, ka, va, s_fin


def setup_inputs(seed: int = 0) -> dict:
    key = jax.random.key(seed)
    ks = jax.random.split(key, 32)

    def nrm(k, shape, scale):
        return scale * jax.random.normal(k, shape, jnp.float32)

    return {
        'x_prompt': nrm(ks[0], (BATCH, SEQ, D_MODEL), 1.0),
        'x_sample': nrm(ks[1], (DEC_BATCH, DEC_SEQ, D_MODEL), 1.0),
        'cache_k': nrm(ks[2], (DEC_BATCH, DEPTH, PAST_LEN, H_KV, HEAD_DIM), 1.0),
        'cache_v': nrm(ks[3], (DEC_BATCH, DEPTH, PAST_LEN, H_KV, HEAD_DIM), 0.5),
        'state_rwkv': nrm(ks[4], (DEC_BATCH, DEPTH, N_DIR, H_RWKV, HEAD_DIM, HEAD_DIM), 0.3),
        'c': nrm(ks[5], (DEC_BATCH, D_MODEL), 1.0),
        'c_ctx': nrm(ks[6], (D_MODEL,), 1.0),
        'w_mod': nrm(ks[7], (DEPTH, D_MODEL, 6 * D_MODEL), 0.5 * D_MODEL ** -0.5),
        'b_mod': nrm(ks[8], (DEPTH, 6 * D_MODEL), 0.1),
        'norm_mix_pre': 1.0 + nrm(ks[9], (DEPTH, D_MODEL), 0.05),
        'norm_mix_post': 1.0 + nrm(ks[10], (DEPTH, D_MODEL), 0.05),
        'norm_ffn_pre': 1.0 + nrm(ks[11], (DEPTH, D_MODEL), 0.05),
        'norm_ffn_post': 1.0 + nrm(ks[12], (DEPTH, D_MODEL), 0.05),
        'w_in': nrm(ks[13], (DEPTH, D_MODEL, D_IN), D_MODEL ** -0.5),
        'w0': 0.5 + nrm(ks[14], (DEPTH, N_DIR, D_RWKV), 0.5),
        'w_up': nrm(ks[15], (DEPTH, N_DIR, LORA_W, D_RWKV), 0.3 * LORA_W ** -0.5),
        'a0': nrm(ks[16], (DEPTH, N_DIR, D_RWKV), 0.3),
        'a_up': nrm(ks[17], (DEPTH, N_DIR, LORA_A, D_RWKV), 0.3 * LORA_A ** -0.5),
        'g_up': nrm(ks[18], (DEPTH, LORA_G, D_RWKV), LORA_G ** -0.5),
        'k_k': 0.85 + nrm(ks[19], (DEPTH, D_RWKV), 0.05),
        'k_a': 1.0 + nrm(ks[20], (DEPTH, D_RWKV), 0.05),
        'r_k': nrm(ks[21], (DEPTH, H_RWKV, HEAD_DIM), 0.1),
        'gn_w': 1.0 + nrm(ks[22], (DEPTH, D_RWKV), 0.05),
        'gn_b': nrm(ks[23], (DEPTH, D_RWKV), 0.02),
        'q_norm': 1.0 + nrm(ks[24], (DEPTH, HEAD_DIM), 0.05),
        'k_norm': 1.0 + nrm(ks[25], (DEPTH, HEAD_DIM), 0.05),
        'w_out': nrm(ks[26], (DEPTH, D_MODEL, D_MODEL), D_MODEL ** -0.5),
        'ffn_up': nrm(ks[27], (DEPTH, D_MODEL, 2 * D_FF), D_MODEL ** -0.5),
        'conv_w': nrm(ks[28], (DEPTH, CONV_W, 2 * D_FF), CONV_W ** -0.5),
        'conv_b': nrm(ks[29], (DEPTH, 2 * D_FF), 0.02),
        'ffn_down': nrm(ks[30], (DEPTH, D_FF, D_MODEL), D_FF ** -0.5),
    }


def reference(x_prompt, x_sample, cache_k, cache_v, state_rwkv, c, c_ctx,
              w_mod, b_mod, norm_mix_pre, norm_mix_post, norm_ffn_pre, norm_ffn_post,
              w_in, w0, w_up, a0, a_up, g_up, k_k, k_a, r_k, gn_w, gn_b,
              q_norm, k_norm, w_out, ffn_up, conv_w, conv_b, ffn_down):
    y_prompt = x_prompt
    y_sample = x_sample
    new_k, new_v, new_s = [], [], []
    for layer in range(DEPTH):
        lp = {
            'norm_mix_pre': norm_mix_pre[layer], 'norm_mix_post': norm_mix_post[layer],
            'norm_ffn_pre': norm_ffn_pre[layer], 'norm_ffn_post': norm_ffn_post[layer],
            'w_in': w_in[layer], 'w0': w0[layer], 'w_up': w_up[layer],
            'a0': a0[layer], 'a_up': a_up[layer], 'g_up': g_up[layer],
            'k_k': k_k[layer], 'k_a': k_a[layer], 'r_k': r_k[layer],
            'gn_w': gn_w[layer], 'gn_b': gn_b[layer],
            'q_norm': q_norm[layer], 'k_norm': k_norm[layer], 'w_out': w_out[layer],
            'ffn_up': ffn_up[layer], 'conv_w': conv_w[layer], 'conv_b': conv_b[layer],
            'ffn_down': ffn_down[layer],
        }
        mod_ctx = ada_ln(c_ctx[None, :], w_mod[layer], b_mod[layer])
        mod_lat = ada_ln(c, w_mod[layer], b_mod[layer])
        y_prompt, k_l, v_l, s_l = trunk_layer(y_prompt, mod_ctx, lp)
        new_k.append(k_l)
        new_v.append(v_l)
        new_s.append(s_l.astype(x_prompt.dtype))
        y_sample, _, _, _ = trunk_layer(
            y_sample, mod_lat, lp,
            ctx=(cache_k[:, layer], cache_v[:, layer], state_rwkv[:, layer]))
    new_cache_k = jnp.stack(new_k, axis=1)
    new_cache_v = jnp.stack(new_v, axis=1)
    new_state_rwkv = jnp.stack(new_s, axis=1)
    return (y_prompt, y_sample, new_cache_k, new_cache_v, new_state_rwkv)
```

```cpp
#include <hip/hip_runtime.h>
#include <stdint.h>
#include <cstdio>

typedef unsigned short bf16_t;
typedef short bf16x8 __attribute__((ext_vector_type(8)));
typedef float f32x4 __attribute__((ext_vector_type(4)));
typedef unsigned u32x4 __attribute__((ext_vector_type(4)));

#ifndef REPP
#define REPP -1
#endif
#define T_CTX 4096
#define T_ALL 12288
#define DM 1024
#define DIN 2560
#define DFF 2816
#define DFF2 5632

#define WS_BAR    0ul
#define WS_MOD    16384ul
#define WS_ROPE   (WS_MOD + 221184ul)
#define WS_WTIN   (WS_ROPE + 262144ul)
#define WS_WTOUT  (WS_WTIN + 5242880ul)
#define WS_WTUP   (WS_WTOUT + 2097152ul)
#define WS_WTDN   (WS_WTUP + 11534336ul)
#define WS_WTLW   (WS_WTDN + 5767168ul)
#define WS_WTLA   (WS_WTLW + 131072ul)
#define WS_WTLG   (WS_WTLA + 131072ul)
#define WS_HBUF   (WS_WTLG + 131072ul)
#define WS_AREA   (WS_HBUF + 25165824ul)
#define WS_PB     (WS_AREA)
#define WS_LB     (WS_PB + 62914560ul)
#define WS_QN     (WS_LB + 62914560ul)
#define WS_KNC    (WS_QN + 12582912ul)
#define WS_KNL    (WS_KNC + 1048576ul)
#define WS_VTC    (WS_KNL + 2621440ul)
#define WS_VTL    (WS_VTC + 1048576ul)
#define WS_YD     (WS_VTL + 2621440ul)
#define WS_RN     (WS_YD + 50331648ul)
#define WS_MODP   (WS_RN + 393216ul)
#define WS_MIX    (WS_AREA)
#define WS_U      (WS_AREA)
#define WS_ACT    (WS_AREA + 138412032ul)
#define WS_F      (WS_AREA)
#define WS_END    (WS_ACT + 69206016ul)
static_assert(WS_END <= 268435456ul, "workspace too large");
static_assert(WS_RN + 393216ul <= 268435456ul, "workspace too large");

#define OUT_CK 12582912ul
#define OUT_CV 13107200ul
#define OUT_ST 13631488ul

struct Params {
  const float *x_prompt, *x_sample, *cache_k, *cache_v, *state_rwkv, *c, *c_ctx, *w_mod, *b_mod,
      *norm_mix_pre, *norm_mix_post, *norm_ffn_pre, *norm_ffn_post, *w_in, *w0, *w_up, *a0, *a_up, *g_up,
      *k_k, *k_a, *r_k, *gn_w, *gn_b, *q_norm, *k_norm, *w_out, *ffn_up, *conv_w, *conv_b, *ffn_down;
  float* out;
  char* ws;
};

#define XB_TMO      128
#define XB_XCNT(j)  (256  + 64 * (j))
#define XB_XSUB(j)  (1280 + 64 * (j))
#define XB_XGEN(j)  (2304 + 64 * (j))
#define XB_TOP      3328
#define XB_TOPGEN   3392
#define XCD_BAR_WORDS 3456
#define XB_QUEUE    3520
#define XB_SPIN_CAP (1u << 22)
#define LAS __attribute__((address_space(3)))

__device__ __forceinline__ unsigned xb_ld(unsigned* p)              { return __hip_atomic_load(p, __ATOMIC_RELAXED, __HIP_MEMORY_SCOPE_AGENT); }
__device__ __forceinline__ unsigned xb_add(unsigned* p, unsigned v) { return __hip_atomic_fetch_add(p, v, __ATOMIC_RELAXED, __HIP_MEMORY_SCOPE_AGENT); }
__device__ __forceinline__ unsigned xb_xcc_id() { return (unsigned)__builtin_amdgcn_s_getreg((3 << 11) | 20) & 0xFu; }
#define XB_SPIN(cond, bar) do { unsigned _sp = 0; while (cond) { __builtin_amdgcn_s_sleep(1); \
    if ((++_sp & 255u) == 0u) { if (xb_ld(&(bar)[XB_TMO])) break; if (_sp > XB_SPIN_CAP) { atomicAdd(&(bar)[XB_TMO], 1u); break; } } } } while (0)

struct XcdBarrier { unsigned* bar; unsigned x; unsigned nloc, nx; };

__device__ __forceinline__ XcdBarrier xcd_barrier_post(unsigned* bar) {
  XcdBarrier b; b.bar = bar; b.x = xb_xcc_id(); b.nloc = 0u; b.nx = 0u;
  if (threadIdx.x == 0) (void)xb_add(&bar[XB_XCNT(b.x)], 1u);
  return b;
}
__device__ __forceinline__ void xcd_barrier_complete(unsigned* bar, unsigned x, unsigned& nloc, unsigned& nx) {
  const unsigned G = gridDim.x * gridDim.y * gridDim.z;
  unsigned sum, cnt, mine, sp = 0u;
  for (;;) {
    sum = 0u; cnt = 0u; mine = 0u;
#pragma unroll
    for (unsigned j = 0; j < 16; ++j) { const unsigned c = xb_ld(&bar[XB_XCNT(j)]); sum += c; cnt += (c > 0u) ? 1u : 0u; mine = (j == x) ? c : mine; }
    if (sum == G) break;
    __builtin_amdgcn_s_sleep(1);
    if ((++sp & 255u) == 0u) { if (xb_ld(&bar[XB_TMO])) break; if (sp > XB_SPIN_CAP) { atomicAdd(&bar[XB_TMO], 1u); break; } }
  }
  nloc = mine > 0u ? mine : 1u; nx = cnt > 0u ? cnt : 1u;
}
__device__ __forceinline__ void xcd_barrier(XcdBarrier& b) {
  asm volatile("s_waitcnt vmcnt(0)" ::: "memory");
  __syncthreads();
  if (threadIdx.x == 0) {
    unsigned* bar = b.bar;
    __builtin_amdgcn_s_waitcnt(0);
    unsigned nloc = b.nloc, nx = b.nx;
    if (nloc == 0u) { xcd_barrier_complete(bar, b.x, nloc, nx); b.nloc = nloc; b.nx = nx; }
    const unsigned old = xb_add(&bar[XB_XSUB(b.x)], 1u);
    const unsigned gen = old / nloc;
    if (old + 1u == (gen + 1u) * nloc) {
      __builtin_amdgcn_fence(__ATOMIC_RELEASE, "agent");
      asm volatile("s_waitcnt vmcnt(0)" ::: "memory");
      const unsigned og = xb_add(&bar[XB_TOP], 1u);
      const unsigned tg = og / nx;
      if (og + 1u == (tg + 1u) * nx) xb_add(&bar[XB_TOPGEN], 1u);
      else XB_SPIN(xb_ld(&bar[XB_TOPGEN]) == tg, bar);
      __builtin_amdgcn_fence(__ATOMIC_ACQUIRE, "agent");
      xb_add(&bar[XB_XGEN(b.x)], 1u);
      asm volatile("s_waitcnt vmcnt(0)" ::: "memory");
    } else {
      XB_SPIN(xb_ld(&bar[XB_XGEN(b.x)]) == gen, bar);
      __builtin_amdgcn_fence(__ATOMIC_ACQUIRE, "agent");
      asm volatile("s_waitcnt vmcnt(0)" ::: "memory");
    }
  }
  __syncthreads();
}

__device__ __forceinline__ unsigned f2bf(float f) { unsigned u = __float_as_uint(f); return (u + 0x7fffu + ((u >> 16) & 1u)) >> 16; }
typedef __bf16 bf16x2_t __attribute__((ext_vector_type(2)));
typedef float f32x2_t __attribute__((ext_vector_type(2)));
__device__ __forceinline__ unsigned pack2(float a, float b) {
  const f32x2_t v = {a, b};
  return __builtin_bit_cast(unsigned, __builtin_convertvector(v, bf16x2_t));
}
__device__ __forceinline__ float bf2f(unsigned b) { return __uint_as_float(b << 16); }
__device__ __forceinline__ float bflo(unsigned u) { return __uint_as_float(u << 16); }
__device__ __forceinline__ float bfhi(unsigned u) { return __uint_as_float(u & 0xffff0000u); }
__device__ __forceinline__ float wave_sum(float v) {
  v += __int_as_float(__builtin_amdgcn_mov_dpp(__float_as_int(v), 0xB1, 0xF, 0xF, true));
  v += __int_as_float(__builtin_amdgcn_mov_dpp(__float_as_int(v), 0x4E, 0xF, 0xF, true));
  v += __int_as_float(__builtin_amdgcn_mov_dpp(__float_as_int(v), 0x141, 0xF, 0xF, true));
  v += __int_as_float(__builtin_amdgcn_mov_dpp(__float_as_int(v), 0x140, 0xF, 0xF, true));
  const float a = __int_as_float(__builtin_amdgcn_readlane(__float_as_int(v), 0));
  const float b = __int_as_float(__builtin_amdgcn_readlane(__float_as_int(v), 16));
  const float c = __int_as_float(__builtin_amdgcn_readlane(__float_as_int(v), 32));
  const float d = __int_as_float(__builtin_amdgcn_readlane(__float_as_int(v), 48));
  return (a + b) + (c + d);
}
__device__ __forceinline__ float quad_sum(float x) {
  x += __int_as_float(__builtin_amdgcn_mov_dpp(__float_as_int(x), 0xB1, 0xF, 0xF, true));
  x += __int_as_float(__builtin_amdgcn_mov_dpp(__float_as_int(x), 0x4E, 0xF, 0xF, true));
  return x;
}
__device__ __forceinline__ float sigmoidf_(float x) { return 1.f / (1.f + __expf(-x)); }
__device__ __forceinline__ const float* xrow(const Params& p, int t) {
  return t < T_CTX ? p.x_prompt + (size_t)t * DM : p.x_sample + (size_t)(t - T_CTX) * DM;
}
__device__ __forceinline__ int modrow(int t) { return t < T_CTX ? 0 : 1 + ((t - T_CTX) >> 10); }

__device__ __forceinline__ unsigned lds_addr(const void* p) { return (unsigned)(size_t)(const LAS char*)p; }
template <int OFF>
__device__ __forceinline__ bf16x8 lds_read128(unsigned addr) {
  bf16x8 v;
  asm volatile("ds_read_b128 %0, %1 offset:%2" : "=v"(v) : "v"(addr), "n"(OFF));
  return v;
}
template <int BUFOFF>
__device__ __forceinline__ void gemm_kstep128(const unsigned (&aaddr)[2], const unsigned (&baddr)[2], f32x4 (&acc)[4][4]) {
  bf16x8 a0[4], b0[4], a1[4], b1[4];
  a0[0] = lds_read128<BUFOFF + 0>(aaddr[0]);    b0[0] = lds_read128<BUFOFF + 16384 + 0>(baddr[0]);
  a0[1] = lds_read128<BUFOFF + 2048>(aaddr[0]); b0[1] = lds_read128<BUFOFF + 16384 + 2048>(baddr[0]);
  a0[2] = lds_read128<BUFOFF + 4096>(aaddr[0]); b0[2] = lds_read128<BUFOFF + 16384 + 4096>(baddr[0]);
  a0[3] = lds_read128<BUFOFF + 6144>(aaddr[0]); b0[3] = lds_read128<BUFOFF + 16384 + 6144>(baddr[0]);
  a1[0] = lds_read128<BUFOFF + 0>(aaddr[1]);    b1[0] = lds_read128<BUFOFF + 16384 + 0>(baddr[1]);
  a1[1] = lds_read128<BUFOFF + 2048>(aaddr[1]); b1[1] = lds_read128<BUFOFF + 16384 + 2048>(baddr[1]);
  a1[2] = lds_read128<BUFOFF + 4096>(aaddr[1]); b1[2] = lds_read128<BUFOFF + 16384 + 4096>(baddr[1]);
  a1[3] = lds_read128<BUFOFF + 6144>(aaddr[1]); b1[3] = lds_read128<BUFOFF + 16384 + 6144>(baddr[1]);
  asm volatile("s_waitcnt lgkmcnt(8)" : "+v"(a0[0]), "+v"(a0[1]), "+v"(a0[2]), "+v"(a0[3]), "+v"(b0[0]), "+v"(b0[1]), "+v"(b0[2]), "+v"(b0[3]));
#pragma unroll
  for (int ni = 0; ni < 4; ++ni)
#pragma unroll
    for (int mi = 0; mi < 4; ++mi)
      acc[ni][mi] = __builtin_amdgcn_mfma_f32_16x16x32_bf16(b0[ni], a0[mi], acc[ni][mi], 0, 0, 0);
  __builtin_amdgcn_sched_barrier(0);
  asm volatile("s_waitcnt lgkmcnt(0)" : "+v"(a1[0]), "+v"(a1[1]), "+v"(a1[2]), "+v"(a1[3]), "+v"(b1[0]), "+v"(b1[1]), "+v"(b1[2]), "+v"(b1[3]));
#pragma unroll
  for (int ni = 0; ni < 4; ++ni)
#pragma unroll
    for (int mi = 0; mi < 4; ++mi)
      acc[ni][mi] = __builtin_amdgcn_mfma_f32_16x16x32_bf16(b1[ni], a1[mi], acc[ni][mi], 0, 0, 0);
  __builtin_amdgcn_sched_barrier(0);
}

template <int STOFF>
__device__ __forceinline__ void gemm_kstep(const unsigned (&aaddr)[2], const unsigned (&baddr)[2], f32x4 (&acc)[4][6]) {
#pragma unroll
  for (int ks = 0; ks < 2; ++ks) {
    bf16x8 a[3], b[4];
    a[0] = lds_read128<STOFF + 0>(aaddr[ks]);     b[0] = lds_read128<STOFF + 0>(baddr[ks]);
    b[1] = lds_read128<STOFF + 2048>(baddr[ks]);  b[2] = lds_read128<STOFF + 4096>(baddr[ks]);
    b[3] = lds_read128<STOFF + 6144>(baddr[ks]);
    a[1] = lds_read128<STOFF + 2048>(aaddr[ks]);  a[2] = lds_read128<STOFF + 4096>(aaddr[ks]);
    asm volatile("s_waitcnt lgkmcnt(2)" : "+v"(a[0]), "+v"(b[0]), "+v"(b[1]), "+v"(b[2]), "+v"(b[3]));
#pragma unroll
    for (int ni = 0; ni < 4; ++ni) acc[ni][0] = __builtin_amdgcn_mfma_f32_16x16x32_bf16(b[ni], a[0], acc[ni][0], 0, 0, 0);
    __builtin_amdgcn_sched_barrier(0);
    a[0] = lds_read128<STOFF + 6144>(aaddr[ks]);
    asm volatile("s_waitcnt lgkmcnt(2)" : "+v"(a[1]));
#pragma unroll
    for (int ni = 0; ni < 4; ++ni) acc[ni][1] = __builtin_amdgcn_mfma_f32_16x16x32_bf16(b[ni], a[1], acc[ni][1], 0, 0, 0);
    __builtin_amdgcn_sched_barrier(0);
    a[1] = lds_read128<STOFF + 8192>(aaddr[ks]);
    asm volatile("s_waitcnt lgkmcnt(2)" : "+v"(a[2]));
#pragma unroll
    for (int ni = 0; ni < 4; ++ni) acc[ni][2] = __builtin_amdgcn_mfma_f32_16x16x32_bf16(b[ni], a[2], acc[ni][2], 0, 0, 0);
    __builtin_amdgcn_sched_barrier(0);
    a[2] = lds_read128<STOFF + 10240>(aaddr[ks]);
    asm volatile("s_waitcnt lgkmcnt(2)" : "+v"(a[0]));
#pragma unroll
    for (int ni = 0; ni < 4; ++ni) acc[ni][3] = __builtin_amdgcn_mfma_f32_16x16x32_bf16(b[ni], a[0], acc[ni][3], 0, 0, 0);
    __builtin_amdgcn_sched_barrier(0);
    asm volatile("s_waitcnt lgkmcnt(1)" : "+v"(a[1]));
#pragma unroll
    for (int ni = 0; ni < 4; ++ni) acc[ni][4] = __builtin_amdgcn_mfma_f32_16x16x32_bf16(b[ni], a[1], acc[ni][4], 0, 0, 0);
    __builtin_amdgcn_sched_barrier(0);
    asm volatile("s_waitcnt lgkmcnt(0)" : "+v"(a[2]));
#pragma unroll
    for (int ni = 0; ni < 4; ++ni) acc[ni][5] = __builtin_amdgcn_mfma_f32_16x16x32_bf16(b[ni], a[2], acc[ni][5], 0, 0, 0);
    __builtin_amdgcn_sched_barrier(0);
  }
}

template <class Epi>
__device__ __forceinline__ void gemm_tile(const bf16_t* __restrict__ A, int lda, const bf16_t* __restrict__ B, int ldb, int K,
                                          char* smem, Epi&& epi, bool prestaged = false, const bf16_t* nA = nullptr, const bf16_t* nB = nullptr) {
  const int tid = threadIdx.x, lane = tid & 63, wave = tid >> 6;
  const int wm = wave >> 1, wn = wave & 1;
  const int l15 = lane & 15, q4 = lane >> 4;
  f32x4 acc[4][6];
#pragma unroll
  for (int i = 0; i < 4; ++i)
#pragma unroll
    for (int j = 0; j < 6; ++j) acc[i][j] = (f32x4){0.f, 0.f, 0.f, 0.f};
  const int lrow = tid >> 3, lch = (tid & 7) ^ (lrow & 7);
  const int prow = ((lrow >> 2) & 3) * 8 + (lrow >> 4) * 4 + (lrow & 3);
  const bf16_t* ap = A + (size_t)lrow * lda + lch * 8;
  const bf16_t* bp = B + (size_t)prow * ldb + lch * 8;
  const size_t lda32 = (size_t)32 * lda, ldb32 = (size_t)32 * ldb;
  const int nk = K >> 6;
  unsigned aaddr[2], baddr[2];
  const unsigned sbase = lds_addr(smem);
#pragma unroll
  for (int ks = 0; ks < 2; ++ks) {
    const int ch = ks * 4 + q4;
    aaddr[ks] = sbase + (wm * 96 + l15) * 128 + ((ch ^ (l15 & 7)) << 4);
    baddr[ks] = sbase + 24576 + (wn * 64 + l15) * 128 + ((ch ^ (l15 & 7)) << 4);
  }
#define GEMM_STAGE(BUF, K0) { _Pragma("unroll") for (int i = 0; i < 6; ++i) \
    __builtin_amdgcn_global_load_lds((const unsigned*)(ap + i * lda32 + (K0)), (LAS unsigned*)(smem + (BUF) * 40960 + i * 4096 + wave * 1024), 16, 0, 0); \
    _Pragma("unroll") for (int i = 0; i < 4; ++i) \
    __builtin_amdgcn_global_load_lds((const unsigned*)(bp + i * ldb32 + (K0)), (LAS unsigned*)(smem + (BUF) * 40960 + 24576 + i * 4096 + wave * 1024), 16, 0, 0); }
  if (!prestaged) {
    __syncthreads();
    GEMM_STAGE(0, 0);
  }
  for (int kt = 0; kt < nk; kt += 2) {
    asm volatile("s_waitcnt vmcnt(0)" ::: "memory");
    __syncthreads();
    if (kt + 1 < nk) GEMM_STAGE(1, (kt + 1) << 6);
    gemm_kstep<0>(aaddr, baddr, acc);
    if (kt + 1 < nk) {
      asm volatile("s_waitcnt vmcnt(0)" ::: "memory");
      __syncthreads();
      if (kt + 2 < nk) { GEMM_STAGE(0, (kt + 2) << 6); }
      else if (nA != nullptr) {
        const bf16_t* nap = nA + (size_t)lrow * lda + lch * 8;
        const bf16_t* nbp = nB + (size_t)prow * ldb + lch * 8;
#pragma unroll
        for (int i = 0; i < 6; ++i)
          __builtin_amdgcn_global_load_lds((const unsigned*)(nap + i * lda32), (LAS unsigned*)(smem + i * 4096 + wave * 1024), 16, 0, 0);
#pragma unroll
        for (int i = 0; i < 4; ++i)
          __builtin_amdgcn_global_load_lds((const unsigned*)(nbp + i * ldb32), (LAS unsigned*)(smem + 24576 + i * 4096 + wave * 1024), 16, 0, 0);
      }
      gemm_kstep<40960>(aaddr, baddr, acc);
    }
  }
#pragma unroll
  for (int np = 0; np < 2; ++np)
#pragma unroll
    for (int mi = 0; mi < 6; ++mi)
      epi(wm * 96 + mi * 16 + l15, wn * 64 + np * 32 + q4 * 8, acc[2 * np][mi], acc[2 * np + 1][mi]);
}

__device__ __forceinline__ bool xcd_tile(int it, int NT, int& mt, int& nt) {
  const int per = (int)(gridDim.x >> 3);
  const int x = blockIdx.x & 7, slot = blockIdx.x >> 3;
  if ((gridDim.x & 7) != 0) {
    const int tile = blockIdx.x + it * gridDim.x;
    if (tile >= 64 * NT) return false;
    mt = tile / NT; nt = tile - mt * NT; return true;
  }
  const int q = slot + it * per;
  if (q >= 8 * NT) return false;
  const int g = q / (4 * NT), r = q - g * 4 * NT;
  nt = r >> 2; mt = 8 * x + 4 * g + (r & 3);
  return true;
}

__device__ void adaln_item(const Params& p, int cb, int kq, char* smem) {
  const int tid = threadIdx.x, lane = tid & 63, wave = tid >> 6;
  float* s_act = (float*)smem;
  float* s_red = s_act + 9 * 1024;
  for (int i = tid; i < 9 * 1024; i += 256) {
    const int b = i >> 10, k = i & 1023;
    const float cv = (b == 0) ? p.c_ctx[k] : p.c[(b - 1) * 1024 + k];
    s_act[i] = cv / (1.f + __expf(-cv));
  }
  __syncthreads();
  const int c0 = cb * 64;
  float acc[9];
#pragma unroll
  for (int b = 0; b < 9; ++b) acc[b] = 0.f;
  const int kbase = (kq < 0) ? wave * 256 : kq * 256 + wave * 64;
  const int klen = (kq < 0) ? 256 : 64;
  const float* wp = p.w_mod + (size_t)kbase * 6144 + c0 + lane;
#pragma unroll 2
  for (int k = 0; k < klen; k += 16) {
    float wv[16];
#pragma unroll
    for (int j = 0; j < 16; ++j) wv[j] = wp[(size_t)(k + j) * 6144];
#pragma unroll
    for (int b = 0; b < 9; ++b) {
#pragma unroll
      for (int j4 = 0; j4 < 4; ++j4) {
        const float4 a = *(const float4*)&s_act[b * 1024 + kbase + k + j4 * 4];
        acc[b] += a.x * wv[j4 * 4] + a.y * wv[j4 * 4 + 1] + a.z * wv[j4 * 4 + 2] + a.w * wv[j4 * 4 + 3];
      }
    }
  }
#pragma unroll
  for (int b = 0; b < 9; ++b) s_red[(wave * 9 + b) * 64 + lane] = acc[b];
  __syncthreads();
  float* mod = (float*)(p.ws + WS_MOD);
  float* modp = (float*)(p.ws + WS_MODP);
  for (int i = tid; i < 9 * 64; i += 256) {
    const int b = i >> 6, l = i & 63;
    const float s = s_red[(0 * 9 + b) * 64 + l] + s_red[(1 * 9 + b) * 64 + l] + s_red[(2 * 9 + b) * 64 + l] + s_red[(3 * 9 + b) * 64 + l];
    if (kq < 0) mod[b * 6144 + c0 + l] = s + p.b_mod[c0 + l];
    else modp[(kq * 9 + b) * 2048 + c0 + l] = s + (kq == 0 ? p.b_mod[c0 + l] : 0.f);
  }
}

__device__ void transpose_tile(const float* __restrict__ W, int N, bf16_t* __restrict__ Wt, int ldt, int k0, int n0, char* smem) {
  const int tid = threadIdx.x;
  float* tile = (float*)smem;
#pragma unroll
  for (int r = 0; r < 4; ++r) {
    const int i = (tid >> 4) + 16 * r, j = (tid & 15) * 4;
    const float4 v = *(const float4*)(W + (size_t)(k0 + i) * N + n0 + j);
    tile[i * 65 + j + 0] = v.x; tile[i * 65 + j + 1] = v.y; tile[i * 65 + j + 2] = v.z; tile[i * 65 + j + 3] = v.w;
  }
  __syncthreads();
  const int n = tid >> 2, ks = (tid & 3) * 16;
  unsigned o[8];
#pragma unroll
  for (int e = 0; e < 8; ++e) o[e] = pack2(tile[(ks + 2 * e) * 65 + n], tile[(ks + 2 * e + 1) * 65 + n]);
  uint4* dst = (uint4*)(Wt + (size_t)(n0 + n) * ldt + k0 + ks);
  dst[0] = make_uint4(o[0], o[1], o[2], o[3]);
  dst[1] = make_uint4(o[4], o[5], o[6], o[7]);
}

__device__ void transpose_item(const Params& p, int idx, char* smem) {
  const float* W; int K, N; bf16_t* Wt; int ntn;
  if (idx < 640) { W = p.w_in; K = 1024; N = 2560; Wt = (bf16_t*)(p.ws + WS_WTIN); }
  else if (idx < 896) { idx -= 640; W = p.w_out; K = 1024; N = 1024; Wt = (bf16_t*)(p.ws + WS_WTOUT); }
  else if (idx < 2304) { idx -= 896; W = p.ffn_up; K = 1024; N = 5632; Wt = (bf16_t*)(p.ws + WS_WTUP); }
  else if (idx < 3008) { idx -= 2304; W = p.ffn_down; K = 2816; N = 1024; Wt = (bf16_t*)(p.ws + WS_WTDN); }
  else if (idx < 3024) { idx -= 3008; const int d = idx >> 3; idx &= 7; W = p.w_up + (size_t)d * 64 * 512; K = 64; N = 512; Wt = (bf16_t*)(p.ws + WS_WTLW) + (size_t)d * 512 * 64; }
  else if (idx < 3040) { idx -= 3024; const int d = idx >> 3; idx &= 7; W = p.a_up + (size_t)d * 64 * 512; K = 64; N = 512; Wt = (bf16_t*)(p.ws + WS_WTLA) + (size_t)d * 512 * 64; }
  else { idx -= 3040; W = p.g_up; K = 128; N = 512; Wt = (bf16_t*)(p.ws + WS_WTLG); }
  ntn = N >> 6;
  const int kt = idx / ntn, nt = idx - kt * ntn;
  transpose_tile(W, N, Wt, K, kt * 64, nt * 64, smem);
}

__device__ void rope_item(const Params& p, int idx) {
  const int e = idx * 256 + threadIdx.x;
  const int tok = e >> 5, s = e & 31;
  const float pos = (float)((s < 16) ? (tok >> 6) : (tok & 63));
  const int f = s & 15;
  const float inv = exp2f(-(float)f * (13.287712379549449f / 16.f));
  const float ang = pos * inv;
  const float rev = ang * 0.15915494309189535f;
  const float fr = rev - rintf(rev);
  float2* tab = (float2*)(p.ws + WS_ROPE);
  tab[e] = make_float2(__builtin_amdgcn_cosf(fr), __builtin_amdgcn_sinf(fr));
}

__device__ void phase0(const Params& p, char* smem) {
  const int total = 128 + 640 + 48 + 128;
  for (int item = blockIdx.x; item < total; item += gridDim.x) {
    if (item < 128) adaln_item(p, item >> 2, item & 3, smem);
    else if (item < 128 + 640) transpose_item(p, item - 128, smem);
    else if (item < 128 + 640 + 48) transpose_item(p, item - 128 - 640 + 3008, smem);
    else rope_item(p, item - 128 - 640 - 48);
    __syncthreads();
  }
}

__device__ void phase1(const Params& p) {
  const int lane = threadIdx.x & 63, wave = threadIdx.x >> 6;
  const float* mod = (const float*)(p.ws + WS_MODP);
  bf16_t* hb = (bf16_t*)(p.ws + WS_HBUF);
  for (int it = blockIdx.x; it < T_ALL / 4; it += gridDim.x) {
    const int t = it * 4 + wave;
    const float* x = xrow(p, t);
    const float* md = mod + modrow(t) * 2048;
    float4 v[4];
    float ss = 0.f;
#pragma unroll
    for (int i = 0; i < 4; ++i) {
      v[i] = *(const float4*)(x + (i * 64 + lane) * 4);
      ss += v[i].x * v[i].x + v[i].y * v[i].y + v[i].z * v[i].z + v[i].w * v[i].w;
    }
    ss = wave_sum(ss);
    const float rstd = rsqrtf(ss * (1.f / 1024.f) + 1e-6f);
#pragma unroll
    for (int i = 0; i < 4; ++i) {
      const int c = (i * 64 + lane) * 4;
      const float4 g = *(const float4*)(p.norm_mix_pre + c);
      float4 sh = *(const float4*)(md + c);
      float4 sc = *(const float4*)(md + 1024 + c);
#pragma unroll
      for (int kq = 1; kq < 4; ++kq) {
        const float4 s2 = *(const float4*)(md + kq * 9 * 2048 + c);
        const float4 c2 = *(const float4*)(md + kq * 9 * 2048 + 1024 + c);
        sh.x += s2.x; sh.y += s2.y; sh.z += s2.z; sh.w += s2.w;
        sc.x += c2.x; sc.y += c2.y; sc.z += c2.z; sc.w += c2.w;
      }
      const float o0 = v[i].x * rstd * g.x * (1.f + sc.x) + sh.x;
      const float o1 = v[i].y * rstd * g.y * (1.f + sc.y) + sh.y;
      const float o2 = v[i].z * rstd * g.z * (1.f + sc.z) + sh.z;
      const float o3 = v[i].w * rstd * g.w * (1.f + sc.w) + sh.w;
      *(uint2*)(hb + (size_t)t * DM + c) = make_uint2(pack2(o0, o1), pack2(o2, o3));
    }
  }
}

__device__ void phase2(const Params& p, char* smem) {
  const bf16_t* hb = (const bf16_t*)(p.ws + WS_HBUF);
  const bf16_t* wt = (const bf16_t*)(p.ws + WS_WTIN);
  bf16_t* pb = (bf16_t*)(p.ws + WS_PB);
  int mt, nt;
  bool have = xcd_tile(0, 20, mt, nt), pre = false;
  for (int it = 0; have; ++it) {
    int mt2 = 0, nt2 = 0;
    const bool have2 = xcd_tile(it + 1, 20, mt2, nt2);
    const bf16_t* nA_ = have2 ? (hb + (size_t)mt2 * 192 * DM) : nullptr;
    const bf16_t* nB_ = have2 ? (wt + (size_t)nt2 * 128 * DM) : nullptr;
    gemm_tile(hb + (size_t)mt * 192 * DM, DM, wt + (size_t)nt * 128 * DM, DM, DM, smem,
              [&](int ml, int nl, f32x4 a, f32x4 b2) {
                const int m = mt * 192 + ml, n = nt * 128 + nl;
                if (n >= 1536 && n < 1600) {
#pragma unroll
                  for (int e = 0; e < 4; ++e) { a[e] = 1.f - 2.f / (__expf(2.f * a[e]) + 1.f); b2[e] = 1.f - 2.f / (__expf(2.f * b2[e]) + 1.f); }
                } else if (n >= 1664 && n < 1792) {
#pragma unroll
                  for (int e = 0; e < 4; ++e) { a[e] = sigmoidf_(a[e]); b2[e] = sigmoidf_(b2[e]); }
                }
                *(u32x4*)(pb + (size_t)m * DIN + n) = (u32x4){pack2(a[0], a[1]), pack2(a[2], a[3]), pack2(b2[0], b2[1]), pack2(b2[2], b2[3])};
              }, pre, nA_, nB_);
    pre = have2; mt = mt2; nt = nt2; have = have2;
  }
}

__device__ __forceinline__ float half_sum(float v);
__device__ void prep_item(const Params& p, int item) {
  const int lane = threadIdx.x & 63, wave = threadIdx.x >> 6;
  const int hh = lane >> 5, l2 = (lane & 31) * 2;
  const bf16_t* pb = (const bf16_t*)(p.ws + WS_PB);
  bf16_t* qn = (bf16_t*)(p.ws + WS_QN);
  const float4* tab4 = (const float4*)(p.ws + WS_ROPE);
  const float2 qg = *(const float2*)(p.q_norm + l2), kg = *(const float2*)(p.k_norm + l2);
  const int slot2 = ((l2 >> 5) * 16 + (l2 & 15)) >> 1;
  const bool hi16 = (l2 & 16) != 0;
  unsigned vacc[4];
  const int t0 = item * 16 + wave * 4;
  const bool lat = t0 >= T_CTX;
  const int b = lat ? ((t0 - T_CTX) >> 10) : (t0 >> 8);
  const int pos0 = lat ? ((t0 - T_CTX) & 1023) : (t0 & 255);
#pragma unroll
  for (int i = 0; i < 4; ++i) {
    const int t = t0 + i, pos = pos0 + i;
    const bf16_t* row = pb + (size_t)t * DIN;
    unsigned qv[4], kx[4];
#pragma unroll
    for (int hp = 0; hp < 4; ++hp) {
      qv[hp] = *(const unsigned*)(row + 1792 + (hp * 2 + hh) * 64 + l2);
      kx[hp] = *(const unsigned*)(row + 512 + (hp * 2 + hh) * 64 + l2);
    }
    const unsigned kv = *(const unsigned*)(row + 2304 + hh * 64 + l2);
    const unsigned vv = *(const unsigned*)(row + 2432 + hh * 64 + l2);
    float4 cssn = make_float4(1.f, 0.f, 1.f, 0.f);
    if (lat) cssn = tab4[pos * 16 + slot2];
#pragma unroll
    for (int hp = 0; hp < 4; ++hp) {
      const float x0 = bflo(qv[hp]), x1 = bfhi(qv[hp]);
      const float ss = half_sum(x0 * x0 + x1 * x1);
      const float rs = rsqrtf(ss * (1.f / 64.f) + 1e-6f);
      float a0 = x0 * rs * qg.x, a1 = x1 * rs * qg.y;
      if (lat) {
        const float p0 = __int_as_float(__builtin_amdgcn_mov_dpp(__float_as_int(a0), 0x128, 0xF, 0xF, true));
        const float p1 = __int_as_float(__builtin_amdgcn_mov_dpp(__float_as_int(a1), 0x128, 0xF, 0xF, true));
        a0 = hi16 ? (p0 * cssn.y + a0 * cssn.x) : (a0 * cssn.x - p0 * cssn.y);
        a1 = hi16 ? (p1 * cssn.w + a1 * cssn.z) : (a1 * cssn.z - p1 * cssn.w);
      }
      const float sc = 0.125f * 1.4426950408889634f;
      *(unsigned*)(qn + (size_t)t * 512 + (hp * 2 + hh) * 64 + l2) = pack2(a0 * sc, a1 * sc);
    }
#pragma unroll
    for (int hp = 0; hp < 4; ++hp) {
      const float2 kw = *(const float2*)(p.k_k + (hp * 2 + hh) * 64 + l2);
      const float k0 = bflo(kx[hp]) * kw.x, k1 = bfhi(kx[hp]) * kw.y;
      const float s2 = half_sum(k0 * k0 + k1 * k1);
      if ((lane & 31) == 0) ((float*)(p.ws + WS_RN))[(size_t)t * 8 + hp * 2 + hh] = rsqrtf(s2 + 1e-12f);
    }
    {
      const int kvh = hh;
      const float x0 = bflo(kv), x1 = bfhi(kv);
      const float ss = half_sum(x0 * x0 + x1 * x1);
      const float rs = rsqrtf(ss * (1.f / 64.f) + 1e-6f);
      float a0 = x0 * rs * kg.x, a1 = x1 * rs * kg.y;
      vacc[i] = vv;
      if (!lat) {
        *(float2*)(p.out + OUT_CK + ((size_t)(b * 256 + pos) * 2 + kvh) * 64 + l2) = make_float2(a0, a1);
        *(float2*)(p.out + OUT_CV + ((size_t)(b * 256 + pos) * 2 + kvh) * 64 + l2) = make_float2(bflo(vv), bfhi(vv));
        *(unsigned*)((bf16_t*)(p.ws + WS_KNC) + ((size_t)(b * 2 + kvh) * 256 + pos) * 64 + l2) = pack2(a0, a1);
      } else {
        const float p0 = __int_as_float(__builtin_amdgcn_mov_dpp(__float_as_int(a0), 0x128, 0xF, 0xF, true));
        const float p1 = __int_as_float(__builtin_amdgcn_mov_dpp(__float_as_int(a1), 0x128, 0xF, 0xF, true));
        a0 = hi16 ? (p0 * cssn.y + a0 * cssn.x) : (a0 * cssn.x - p0 * cssn.y);
        a1 = hi16 ? (p1 * cssn.w + a1 * cssn.z) : (a1 * cssn.z - p1 * cssn.w);
        *(unsigned*)((bf16_t*)(p.ws + WS_KNL) + ((size_t)(b * 2 + kvh) * 1280 + pos) * 64 + l2) = pack2(a0, a1);
      }
    }
  }
  {
    const int kvh = hh;
    const uint2 lo = make_uint2((vacc[0] & 0xffffu) | (vacc[1] << 16), (vacc[2] & 0xffffu) | (vacc[3] << 16));
    const uint2 hi = make_uint2((vacc[0] >> 16) | (vacc[1] & 0xffff0000u), (vacc[2] >> 16) | (vacc[3] & 0xffff0000u));
    bf16_t* vb = lat ? ((bf16_t*)(p.ws + WS_VTL) + ((size_t)(b * 2 + kvh) * 64 + l2) * 1280 + pos0)
                     : ((bf16_t*)(p.ws + WS_VTC) + ((size_t)(b * 2 + kvh) * 64 + l2) * 256 + pos0);
    const int ld = lat ? 1280 : 256;
    *(uint2*)vb = lo;
    *(uint2*)(vb + ld) = hi;
  }
}

__device__ void cache_item(const Params& p, int item) {
  for (int i = 0; i < 4; ++i) {
    const int e = item * 1024 + i * 256 + threadIdx.x;
    const int d = e & 63, kvh = (e >> 6) & 1, pp = (e >> 7) & 255, b = e >> 15;
    ((bf16_t*)(p.ws + WS_KNL))[((size_t)(b * 2 + kvh) * 1280 + 1024 + pp) * 64 + d] = (bf16_t)f2bf(p.cache_k[e]);
  }
  {
    const int q = item * 256 + threadIdx.x;
    const int d = q & 63, kvh = (q >> 6) & 1, pg = (q >> 7) & 63, b = q >> 13;
    unsigned v[4];
#pragma unroll
    for (int j = 0; j < 4; ++j) v[j] = f2bf(p.cache_v[(((size_t)b * 256 + pg * 4 + j) * 2 + kvh) * 64 + d]);
    *(uint2*)((bf16_t*)(p.ws + WS_VTL) + ((size_t)(b * 2 + kvh) * 64 + d) * 1280 + 1024 + pg * 4) = make_uint2(v[0] | (v[1] << 16), v[2] | (v[3] << 16));
  }
}

__device__ void lora_tile(const Params& p, int tile, char* smem) {
  const bf16_t* pb = (const bf16_t*)(p.ws + WS_PB);
  bf16_t* lb = (bf16_t*)(p.ws + WS_LB);
  const int mt = tile / 20, nt = tile - mt * 20;
  const int grp = nt >> 2, n0 = (nt & 3) * 128;
  const bf16_t* A; const bf16_t* B; int K;
  if (grp < 2) { A = pb + 1536; K = 64; B = (const bf16_t*)(p.ws + WS_WTLW) + (size_t)(grp * 512 + n0) * 64; }
  else if (grp < 4) { A = pb + 1600; K = 64; B = (const bf16_t*)(p.ws + WS_WTLA) + (size_t)((grp - 2) * 512 + n0) * 64; }
  else { A = pb + 1664; K = 128; B = (const bf16_t*)(p.ws + WS_WTLG) + (size_t)n0 * 128; }
  gemm_tile(A + (size_t)mt * 192 * DIN, DIN, B, K, K, smem,
            [&](int ml, int nl, f32x4 a, f32x4 b2) {
              const int m = mt * 192 + ml, c = n0 + nl;
              if (grp < 2) {
#pragma unroll
                for (int e = 0; e < 4; ++e) {
                  a[e] = __expf(-0.6065306597126334f * sigmoidf_(p.w0[grp * 512 + c + e] + a[e]));
                  b2[e] = __expf(-0.6065306597126334f * sigmoidf_(p.w0[grp * 512 + c + 4 + e] + b2[e]));
                }
              } else if (grp < 4) {
#pragma unroll
                for (int e = 0; e < 4; ++e) {
                  a[e] = sigmoidf_(p.a0[(grp - 2) * 512 + c + e] + a[e]);
                  b2[e] = sigmoidf_(p.a0[(grp - 2) * 512 + c + 4 + e] + b2[e]);
                }
              }
              *(u32x4*)(lb + (size_t)m * DIN + grp * 512 + c) = (u32x4){pack2(a[0], a[1]), pack2(a[2], a[3]), pack2(b2[0], b2[1]), pack2(b2[2], b2[3])};
            });
}

__device__ void lora_item(const Params& p, int item, char* smem) {
  const bf16_t* pb = (const bf16_t*)(p.ws + WS_PB);
  bf16_t* lb = (bf16_t*)(p.ws + WS_LB);
  const int mt = item >> 2, sub = item & 3, pair = sub >> 1, j0 = (sub & 1) * 4;
  const int tid = threadIdx.x, lane = tid & 63, wave = tid >> 6;
  const int wm = wave >> 1, wn = wave & 1, l15 = lane & 15, q4 = lane >> 4;
  const int lrow = tid >> 3, lch = (tid & 7) ^ (lrow & 7);
  const bf16_t* ap = pb + (size_t)(mt * 128 + lrow) * DIN + (pair ? 1600 : 1536) + lch * 8;
  const bf16_t* bbase = (const bf16_t*)(p.ws + (pair ? WS_WTLA : WS_WTLW));
  const int prow = ((lrow >> 2) & 3) * 8 + (lrow >> 4) * 4 + (lrow & 3);
  unsigned aaddr[2], baddr[2];
  const unsigned sbase = lds_addr(smem);
#pragma unroll
  for (int ks = 0; ks < 2; ++ks) {
    const int ch = ks * 4 + q4;
    aaddr[ks] = sbase + (wm * 64 + l15) * 128 + ((ch ^ (l15 & 7)) << 4);
    baddr[ks] = sbase + (wn * 64 + l15) * 128 + ((ch ^ (l15 & 7)) << 4);
  }
#define LORA_STAGE_B(BUF, J) { const bf16_t* bp_ = bbase + (size_t)((J) * 128 + prow) * 64 + lch * 8; _Pragma("unroll") for (int i = 0; i < 4; ++i) \
    __builtin_amdgcn_global_load_lds((const unsigned*)(bp_ + (size_t)(32 * i) * 64), (LAS unsigned*)(smem + (BUF) * 32768 + 16384 + i * 4096 + wave * 1024), 16, 0, 0); }
  __syncthreads();
#pragma unroll
  for (int i = 0; i < 4; ++i) {
    __builtin_amdgcn_global_load_lds((const unsigned*)(ap + (size_t)(32 * i) * DIN), (LAS unsigned*)(smem + i * 4096 + wave * 1024), 16, 0, 0);
    __builtin_amdgcn_global_load_lds((const unsigned*)(ap + (size_t)(32 * i) * DIN), (LAS unsigned*)(smem + 32768 + i * 4096 + wave * 1024), 16, 0, 0);
  }
  LORA_STAGE_B(0, j0);
#define LORA_STEP(JJ, BUFOFF_) { \
    const int j = j0 + (JJ); \
    asm volatile("s_waitcnt vmcnt(0)" ::: "memory"); \
    __syncthreads(); \
    if ((JJ) + 1 < 4) LORA_STAGE_B(((JJ) + 1) & 1, j + 1); \
    f32x4 acc[4][4]; \
    _Pragma("unroll") for (int x = 0; x < 4; ++x) _Pragma("unroll") for (int y = 0; y < 4; ++y) acc[x][y] = (f32x4){0.f, 0.f, 0.f, 0.f}; \
    gemm_kstep128<BUFOFF_>(aaddr, baddr, acc); \
    const int grp = pair * 2 + (j >> 2), n0 = (j & 3) * 128; \
    _Pragma("unroll") for (int np = 0; np < 2; ++np) { \
      const int c = n0 + wn * 64 + np * 32 + q4 * 8; \
      const float* wq = (pair ? p.a0 : p.w0) + (grp & 1) * 512 + c; \
      const float4 w0 = *(const float4*)wq, w1 = *(const float4*)(wq + 4); \
      _Pragma("unroll") for (int mi = 0; mi < 4; ++mi) { \
        f32x4 a = acc[2 * np][mi], b2 = acc[2 * np + 1][mi]; \
        const int m = mt * 128 + wm * 64 + mi * 16 + l15; \
        a[0] = sigmoidf_(w0.x + a[0]); a[1] = sigmoidf_(w0.y + a[1]); a[2] = sigmoidf_(w0.z + a[2]); a[3] = sigmoidf_(w0.w + a[3]); \
        b2[0] = sigmoidf_(w1.x + b2[0]); b2[1] = sigmoidf_(w1.y + b2[1]); b2[2] = sigmoidf_(w1.z + b2[2]); b2[3] = sigmoidf_(w1.w + b2[3]); \
        if (pair == 0) { \
          _Pragma("unroll") for (int e = 0; e < 4; ++e) { a[e] = __expf(-0.6065306597126334f * a[e]); b2[e] = __expf(-0.6065306597126334f * b2[e]); } \
        } \
        *(u32x4*)(lb + (size_t)m * DIN + grp * 512 + c) = (u32x4){pack2(a[0], a[1]), pack2(a[2], a[3]), pack2(b2[0], b2[1]), pack2(b2[2], b2[3])}; \
      } \
      __builtin_amdgcn_sched_barrier(0); \
    } }
  for (int jp = 0; jp < 4; jp += 2) {
    LORA_STEP(jp, 0);
    LORA_STEP(jp + 1, 32768);
  }
}

__device__ void phase3(const Params& p, char* smem, int mask = 3) {
  const int n1 = 384, n2 = 256, np = T_ALL / 16, nc = 256;
  for (int item = blockIdx.x; item < n1 + n2 + np + nc; item += gridDim.x) {
    if (item < n1) { if (mask & 1) lora_item(p, item, smem); }
    else if (item < n1 + n2) { if (mask & 1) { const int t2 = item - n1; lora_tile(p, (t2 >> 2) * 20 + 16 + (t2 & 3), smem); } }
    else if (item < n1 + n2 + np) { if (mask & 2) prep_item(p, item - n1 - n2); }
    else { if (mask & 2) cache_item(p, item - n1 - n2 - np); }
  }
}

struct ScanOps { f32x4 kk[2], w[2], b[2], kd[2], r[2]; float v; };
__device__ __forceinline__ void scan_load_ops(ScanOps& o, const float* tk, int kq, int row) {
  const float* q = tk + kq * 8;
  o.kk[0] = *(const f32x4*)(q);       o.kk[1] = *(const f32x4*)(q + 4);
  o.w[0]  = *(const f32x4*)(q + 64);  o.w[1]  = *(const f32x4*)(q + 68);
  o.b[0]  = *(const f32x4*)(q + 128); o.b[1]  = *(const f32x4*)(q + 132);
  o.kd[0] = *(const f32x4*)(q + 192); o.kd[1] = *(const f32x4*)(q + 196);
  o.r[0]  = *(const f32x4*)(q + 256); o.r[1]  = *(const f32x4*)(q + 260);
  o.v = tk[320 + row];
}
__device__ __forceinline__ float oct_sum(float x) {
  x += __int_as_float(__builtin_amdgcn_mov_dpp(__float_as_int(x), 0xB1, 0xF, 0xF, true));
  x += __int_as_float(__builtin_amdgcn_mov_dpp(__float_as_int(x), 0x4E, 0xF, 0xF, true));
  x += __int_as_float(__builtin_amdgcn_mov_dpp(__float_as_int(x), 0x141, 0xF, 0xF, true));
  return x;
}
__device__ __forceinline__ float scan_step(float (&S)[8], const ScanOps& o) {
  float s0 = S[0] * o.kk[0][0], s1 = S[1] * o.kk[0][1], s2 = S[2] * o.kk[0][2], s3 = S[3] * o.kk[0][3];
  s0 += S[4] * o.kk[1][0]; s1 += S[5] * o.kk[1][1]; s2 += S[6] * o.kk[1][2]; s3 += S[7] * o.kk[1][3];
  const float sa = -oct_sum((s0 + s1) + (s2 + s3));
  float y0 = 0.f, y1 = 0.f, y2 = 0.f, y3 = 0.f;
#pragma unroll
  for (int q = 0; q < 2; ++q) {
    S[q * 4 + 0] = S[q * 4 + 0] * o.w[q][0] + (sa * o.b[q][0] + o.v * o.kd[q][0]);
    S[q * 4 + 1] = S[q * 4 + 1] * o.w[q][1] + (sa * o.b[q][1] + o.v * o.kd[q][1]);
    S[q * 4 + 2] = S[q * 4 + 2] * o.w[q][2] + (sa * o.b[q][2] + o.v * o.kd[q][2]);
    S[q * 4 + 3] = S[q * 4 + 3] * o.w[q][3] + (sa * o.b[q][3] + o.v * o.kd[q][3]);
    y0 += S[q * 4 + 0] * o.r[q][0]; y1 += S[q * 4 + 1] * o.r[q][1];
    y2 += S[q * 4 + 2] * o.r[q][2]; y3 += S[q * 4 + 3] * o.r[q][3];
  }
  return oct_sum((y0 + y1) + (y2 + y3));
}

__device__ void scan_chain(const Params& p, int item, char* smem) {
  const int tid = threadIdx.x, lane = tid & 63, wave = tid >> 6;
  const int half = item & 1, chain = item >> 1;
  int b, h, d, L, tb; bool lat;
  if (chain < 128) { lat = true; b = chain >> 4; h = (chain >> 1) & 7; d = chain & 1; L = 1024; tb = T_CTX + b * 1024; }
  else { const int c2 = chain - 128; lat = false; b = c2 >> 4; h = (c2 >> 1) & 7; d = c2 & 1; L = 256; tb = b * 256; }
  const int row = half * 32 + wave * 8 + (lane >> 3), kq = lane & 7;
  float S[8];
  if (lat) {
    const float* sp = p.state_rwkv + ((((size_t)b * 2 + d) * 8 + h) * 64 + row) * 64 + kq * 8;
    const f32x4 v0 = *(const f32x4*)sp, v1 = *(const f32x4*)(sp + 4);
    S[0] = v0[0]; S[1] = v0[1]; S[2] = v0[2]; S[3] = v0[3]; S[4] = v1[0]; S[5] = v1[1]; S[6] = v1[2]; S[7] = v1[3];
  } else {
#pragma unroll
    for (int j = 0; j < 8; ++j) S[j] = 0.f;
  }
  float* buf = (float*)smem;
  const bf16_t* pb = (const bf16_t*)(p.ws + WS_PB);
  const bf16_t* lb = (const bf16_t*)(p.ws + WS_LB);
  float* yd = (float*)(p.ws + WS_YD) + (size_t)d * T_ALL * 512;
  const int c = h * 64 + lane;
  const float kkc = p.k_k[c], kac = p.k_a[c];
  unsigned rr[4], rk[4], rv[4], rw[4], ra[4];
  const int nch = L >> 4;
#define SCAN_LOAD(CH) { _Pragma("unroll") for (int i = 0; i < 4; ++i) { const int s_ = (CH) * 16 + wave + 4 * i; const int pos_ = d ? (L - 1 - s_) : s_; \
    const size_t t_ = (size_t)(tb + pos_) * DIN; rr[i] = pb[t_ + c]; rk[i] = pb[t_ + 512 + c]; rv[i] = pb[t_ + 1024 + c]; \
    rw[i] = lb[t_ + d * 512 + c]; ra[i] = lb[t_ + 1024 + d * 512 + c]; } }
#define SCAN_STAGE(BI) { _Pragma("unroll") for (int i = 0; i < 4; ++i) { const int slot_ = wave + 4 * i; \
    const float r_ = bf2f(rr[i]), k_ = bf2f(rk[i]), v_ = bf2f(rv[i]), w_ = bf2f(rw[i]), a_ = bf2f(ra[i]); \
    const float kkr_ = k_ * kkc; const float ss_ = wave_sum(kkr_ * kkr_); const float kk_ = kkr_ * rsqrtf(ss_ + 1e-12f); \
    const float kd_ = k_ * (1.f + (a_ - 1.f) * kac); float* o_ = buf + (((BI) * 16 + slot_) * 6) * 64 + lane; \
    o_[0] = kk_; o_[64] = w_; o_[128] = kk_ * a_; o_[192] = kd_; o_[256] = r_; o_[320] = v_; } }
  SCAN_LOAD(0);
  SCAN_STAGE(0);
  __syncthreads();
  if (nch > 1) SCAN_LOAD(1);
  float* ybase = yd + (size_t)tb * 512 + h * 64 + row;
  for (int ch = 0; ch < nch; ++ch) {
    const float* cb = buf + (ch & 1) * (16 * 6 * 64);
    ScanOps oa, ob;
    scan_load_ops(oa, cb, kq, row);
#pragma unroll
    for (int s = 0; s < 16; s += 2) {
      scan_load_ops(ob, cb + (s + 1) * 384, kq, row);
      const float ya = scan_step(S, oa);
      if (s + 2 < 16) scan_load_ops(oa, cb + (s + 2) * 384, kq, row);
      const float yb = scan_step(S, ob);
      const int sg = ch * 16 + s;
      const int pa = d ? (L - 1 - sg) : sg, pbb = d ? (L - 2 - sg) : (sg + 1);
      if (kq == 0) { ybase[(size_t)pa * 512] = ya; ybase[(size_t)pbb * 512] = yb; }
    }
    if (ch + 1 < nch) SCAN_STAGE((ch + 1) & 1);
    __syncthreads();
    if (ch + 2 < nch) SCAN_LOAD(ch + 2);
  }
  if (!lat) {
    float* so = p.out + OUT_ST + ((((size_t)b * 2 + d) * 8 + h) * 64 + row) * 64 + kq * 8;
    *(f32x4*)so = (f32x4){S[0], S[1], S[2], S[3]};
    *(f32x4*)(so + 4) = (f32x4){S[4], S[5], S[6], S[7]};
  }
  __syncthreads();
}

__device__ __forceinline__ float row16_sum(float x) {
  x += __int_as_float(__builtin_amdgcn_mov_dpp(__float_as_int(x), 0xB1, 0xF, 0xF, true));
  x += __int_as_float(__builtin_amdgcn_mov_dpp(__float_as_int(x), 0x4E, 0xF, 0xF, true));
  x += __int_as_float(__builtin_amdgcn_mov_dpp(__float_as_int(x), 0x141, 0xF, 0xF, true));
  x += __int_as_float(__builtin_amdgcn_mov_dpp(__float_as_int(x), 0x140, 0xF, 0xF, true));
  return x;
}
__device__ __forceinline__ bf16x8 mk8(unsigned a, unsigned b, unsigned c, unsigned d) {
  union { u32x4 u; bf16x8 v; } cv;
  cv.u = (u32x4){a, b, c, d};
  return cv.v;
}
#define DPP_F(X, CTRL) __int_as_float(__builtin_amdgcn_mov_dpp(__float_as_int(X), CTRL, 0xF, 0xF, true))
#define DPP_SHR1(X, N) __int_as_float(__builtin_amdgcn_update_dpp(0x3f800000, __float_as_int(X), 0x110 + (N), 0xF, 0xF, false))
__device__ void scan_chunked(const Params& p, int chain, char* smem) {
  const int tid = threadIdx.x, lane = tid & 63, l15 = lane & 15, q4 = lane >> 4;
  const int wave = __builtin_amdgcn_readfirstlane(tid >> 6);
  int b, h, d, L, tb; bool lat;
  if (chain < 128) { lat = true; b = chain >> 4; h = (chain >> 1) & 7; d = chain & 1; L = 1024; tb = T_CTX + b * 1024; }
  else { const int c2 = chain - 128; lat = false; b = c2 >> 4; h = (c2 >> 1) & 7; d = c2 & 1; L = 256; tb = b * 256; }
  __syncthreads();
  for (int i = tid; i < 512; i += 256) {
    ((bf16_t*)(smem + 14592))[i] = 0; ((bf16_t*)(smem + 16640))[i] = 0;
    ((bf16_t*)(smem + 17664 + 14592))[i] = 0; ((bf16_t*)(smem + 17664 + 16640))[i] = 0;
  }
  const int val = wave * 16 + l15;
  f32x4 st[4];
  if (lat) {
    const float* sp = p.state_rwkv + ((((size_t)b * 2 + d) * 8 + h) * 64 + val) * 64 + q4 * 4;
#pragma unroll
    for (int mb = 0; mb < 4; ++mb) st[mb] = *(const f32x4*)(sp + mb * 16);
  } else {
#pragma unroll
    for (int mb = 0; mb < 4; ++mb) st[mb] = (f32x4){0.f, 0.f, 0.f, 0.f};
  }
  const int te = tid & 15, cg = tid >> 4, c0 = cg * 4;
  const f32x4 kkc = *(const f32x4*)(p.k_k + h * 64 + c0), kac = *(const f32x4*)(p.k_a + h * 64 + c0);
  const bf16_t* pb = (const bf16_t*)(p.ws + WS_PB);
  const bf16_t* lb = (const bf16_t*)(p.ws + WS_LB);
  const float* rnp = (const float*)(p.ws + WS_RN);
  bf16_t* yd = (bf16_t*)(p.ws + WS_YD) + (size_t)d * T_ALL * 512;
  const int g_chunk = (cg >> 3) * 4 + (cg & 3), g_half = ((cg >> 2) & 1) * 8;
  const int g_off = te * 128 + ((g_chunk ^ (te & 7)) << 4) + g_half;
  const int m_slot = ((te >> 2) * 8 + (te & 3)) * 2;
  uint2 rr[4], rk[4], rv[4], rw[4], ra[4];
  float rn[4];
  const int nch = L >> 4;
#define CS_LOAD(SL, CH) { const int s_ = (CH) * 16 + te; const int pos_ = d ? (L - 1 - s_) : s_; const size_t t_ = (size_t)(tb + pos_) * DIN + h * 64 + c0; \
    rr[SL] = *(const uint2*)(pb + t_); rk[SL] = *(const uint2*)(pb + t_ + 512); rv[SL] = *(const uint2*)(pb + t_ + 1024); \
    rw[SL] = *(const uint2*)(lb + t_ + d * 512); ra[SL] = *(const uint2*)(lb + t_ + 1024 + d * 512); rn[SL] = rnp[(size_t)(tb + pos_) * 8 + h]; }
  CS_LOAD(0, 0); CS_LOAD(1, 1); CS_LOAD(2, 2); CS_LOAD(3, 3);
  __syncthreads();
  for (int ch4 = 0; ch4 < nch; ch4 += 4) {
#pragma unroll
  for (int sl = 0; sl < 4; ++sl) {
    const int ch = ch4 + sl;
    char* bufp = smem + (sl & 1) * 17664;
    char* G1 = bufp; char* HH = bufp + 4096; char* M3 = bufp + 8192; char* VT = bufp + 12288;
    float* GC = (float*)(bufp + 14336); char* MB = bufp + 14592; char* M2 = bufp + 15616; char* ML = bufp + 16640;
    {
      const float r4[4] = {bflo(rr[sl].x), bfhi(rr[sl].x), bflo(rr[sl].y), bfhi(rr[sl].y)};
      const float k4[4] = {bflo(rk[sl].x), bfhi(rk[sl].x), bflo(rk[sl].y), bfhi(rk[sl].y)};
      const float w4[4] = {bflo(rw[sl].x), bfhi(rw[sl].x), bflo(rw[sl].y), bfhi(rw[sl].y)};
      const float a4[4] = {bflo(ra[sl].x), bfhi(ra[sl].x), bflo(ra[sl].y), bfhi(ra[sl].y)};
      const uint2 vraw = rv[sl];
      const float rinv = rn[sl];
      float kap[4], rh[4], bb[4], kb[4], bh[4], k2[4], gcv[4];
#pragma unroll
      for (int e = 0; e < 4; ++e) {
        const float kk = k4[e] * kkc[e] * rinv;
        const float kd = k4[e] * (1.f + (a4[e] - 1.f) * kac[e]);
        const float be = kk * a4[e];
        float g = w4[e];
        g *= DPP_SHR1(g, 1); g *= DPP_SHR1(g, 2); g *= DPP_SHR1(g, 4); g *= DPP_SHR1(g, 8);
        const float gm1 = DPP_SHR1(g, 1);
        float tot = w4[e];
        tot *= DPP_F(tot, 0xB1); tot *= DPP_F(tot, 0x4E); tot *= DPP_F(tot, 0x141); tot *= DPP_F(tot, 0x140);
        const float ib = __builtin_amdgcn_rcpf(g);
        kap[e] = kk * gm1; rh[e] = r4[e] * g;
        bb[e] = be * ib; kb[e] = kd * ib;
        bh[e] = bb[e] * tot; k2[e] = kb[e] * tot; gcv[e] = tot;
      }
      *(uint2*)(G1 + g_off) = make_uint2(pack2(kap[0], kap[1]), pack2(kap[2], kap[3]));
      *(uint2*)(G1 + 2048 + g_off) = make_uint2(pack2(rh[0], rh[1]), pack2(rh[2], rh[3]));
      *(uint2*)(HH + g_off) = make_uint2(pack2(bb[0], bb[1]), pack2(bb[2], bb[3]));
      *(uint2*)(HH + 2048 + g_off) = make_uint2(pack2(kb[0], kb[1]), pack2(kb[2], kb[3]));
#pragma unroll
      for (int e = 0; e < 4; ++e) {
        const unsigned pm = pack2(-bh[e], k2[e]);
        *(bf16_t*)(M3 + (c0 + e) * 64 + m_slot) = (bf16_t)(pm & 0xffffu);
        *(bf16_t*)(M3 + (c0 + e) * 64 + m_slot + 8) = (bf16_t)(pm >> 16);
      }
      *(bf16_t*)(VT + (c0 + 0) * 32 + te * 2) = (bf16_t)(vraw.x & 0xffffu);
      *(bf16_t*)(VT + (c0 + 1) * 32 + te * 2) = (bf16_t)(vraw.x >> 16);
      *(bf16_t*)(VT + (c0 + 2) * 32 + te * 2) = (bf16_t)(vraw.y & 0xffffu);
      *(bf16_t*)(VT + (c0 + 3) * 32 + te * 2) = (bf16_t)(vraw.y >> 16);
      if (te == 15) *(f32x4*)(GC + c0) = (f32x4){gcv[0], gcv[1], gcv[2], gcv[3]};
    }
    __syncthreads();
    if (ch + 4 < nch) CS_LOAD(sl, ch + 4);
    {
      const int gi = wave >> 1, hi = wave & 1;
      f32x4 dacc = (f32x4){0.f, 0.f, 0.f, 0.f};
#pragma unroll
      for (int s2 = 0; s2 < 2; ++s2) {
        const int sw = ((s2 * 4 + q4) ^ (l15 & 7)) << 4;
        const bf16x8 af = *(const bf16x8*)(G1 + (gi * 16 + l15) * 128 + sw);
        const bf16x8 bv = *(const bf16x8*)(HH + (hi * 16 + l15) * 128 + sw);
        dacc = __builtin_amdgcn_mfma_f32_16x16x32_bf16(af, bv, dacc, 0, 0, 0);
      }
      const int sl2 = ((l15 >> 2) * 8 + (l15 & 3)) * 2;
      if (wave == 0) {
        float li[16];
#pragma unroll
        for (int t = 0; t < 16; ++t) {
          float v = (l15 == t) ? 1.f : 0.f;
#pragma unroll
          for (int i = 0; i < t; ++i) {
            const float a_ti = __int_as_float(__builtin_amdgcn_readlane(__float_as_int(dacc[t & 3]), (t >> 2) * 16 + i));
            v -= a_ti * li[i];
          }
          li[t] = v;
          __builtin_amdgcn_sched_barrier(0);
        }
#pragma unroll
        for (int j = 0; j < 4; ++j) {
          float lv = (q4 == 0) ? li[j] : (q4 == 1) ? li[4 + j] : (q4 == 2) ? li[8 + j] : li[12 + j];
          const unsigned pm = pack2(lv, 0.f);
          *(bf16_t*)(ML + (q4 * 4 + j) * 64 + sl2) = (bf16_t)(pm & 0xffffu);
        }
      } else {
#pragma unroll
        for (int j = 0; j < 4; ++j) {
          const int t = q4 * 4 + j, i = l15;
          float xv = dacc[j];
          if (wave == 1) xv = (i < t) ? xv : 0.f;
          else if (wave == 2) xv = (i <= t) ? -xv : 0.f;
          else xv = (i <= t) ? xv : 0.f;
          const unsigned pm = pack2(xv, 0.f);
          char* dst = (wave == 1) ? (MB + t * 64 + sl2 + 8) : (wave == 2) ? (M2 + t * 64 + sl2) : (M2 + t * 64 + sl2 + 8);
          *(bf16_t*)dst = (bf16_t)(pm & 0xffffu);
        }
      }
    }
    f32x4 xk = (f32x4){0.f, 0.f, 0.f, 0.f}, xr = xk;
#pragma unroll
    for (int s2 = 0; s2 < 2; ++s2) {
      const bf16x8 sb = mk8(pack2(st[2 * s2][0], st[2 * s2][1]), pack2(st[2 * s2][2], st[2 * s2][3]),
                            pack2(st[2 * s2 + 1][0], st[2 * s2 + 1][1]), pack2(st[2 * s2 + 1][2], st[2 * s2 + 1][3]));
      const int sw = ((s2 * 4 + q4) ^ (l15 & 7)) << 4;
      const bf16x8 ak = *(const bf16x8*)(G1 + l15 * 128 + sw);
      const bf16x8 ar = *(const bf16x8*)(G1 + 2048 + l15 * 128 + sw);
      xk = __builtin_amdgcn_mfma_f32_16x16x32_bf16(ak, sb, xk, 0, 0, 0);
      xr = __builtin_amdgcn_mfma_f32_16x16x32_bf16(ar, sb, xr, 0, 0, 0);
    }
    __syncthreads();
    const uint2 vt = *(const uint2*)(VT + val * 32 + q4 * 8);
    const f32x4 z = __builtin_amdgcn_mfma_f32_16x16x32_bf16(*(const bf16x8*)(MB + l15 * 64 + q4 * 16), mk8(0u, 0u, vt.x, vt.y), xk, 0, 0, 0);
    const f32x4 pt = __builtin_amdgcn_mfma_f32_16x16x32_bf16(*(const bf16x8*)(ML + l15 * 64 + q4 * 16),
                                                            mk8(pack2(z[0], z[1]), pack2(z[2], z[3]), 0u, 0u), (f32x4){0.f, 0.f, 0.f, 0.f}, 0, 0, 0);
    const bf16x8 b2 = mk8(pack2(pt[0], pt[1]), pack2(pt[2], pt[3]), vt.x, vt.y);
    const f32x4 yt = __builtin_amdgcn_mfma_f32_16x16x32_bf16(*(const bf16x8*)(M2 + l15 * 64 + q4 * 16), b2, xr, 0, 0, 0);
#pragma unroll
    for (int j = 0; j < 4; ++j) {
      const int s_ = ch * 16 + q4 * 4 + j;
      const int pos = d ? (L - 1 - s_) : s_;
      yd[(size_t)(tb + pos) * 512 + h * 64 + val] = (bf16_t)f2bf(yt[j]);
    }
#pragma unroll
    for (int mb = 0; mb < 4; ++mb) {
      const f32x4 g = *(const f32x4*)(GC + mb * 16 + q4 * 4);
      st[mb] = st[mb] * g;
      st[mb] = __builtin_amdgcn_mfma_f32_16x16x32_bf16(*(const bf16x8*)(M3 + (mb * 16 + l15) * 64 + q4 * 16), b2, st[mb], 0, 0, 0);
    }
  }
  }
  if (!lat) {
    float* so = p.out + OUT_ST + ((((size_t)b * 2 + d) * 8 + h) * 64 + val) * 64 + q4 * 4;
#pragma unroll
    for (int mb = 0; mb < 4; ++mb) *(f32x4*)(so + mb * 16) = st[mb];
  }
  __syncthreads();
}

__device__ void attn_item(const Params& p, int item, char* smem) {
  const int tid = threadIdx.x, lane = tid & 63, wave = tid >> 6;
  const int l15 = lane & 15, q4 = lane >> 4;
  int b, hq, qt, Lk, qtok0; const bf16_t* kn; const bf16_t* vt;
  if (item < 512) {
    b = item >> 6; hq = (item >> 3) & 7; qt = item & 7; Lk = 1280; qtok0 = T_CTX + b * 1024 + qt * 128;
    const int kvh = hq >> 2;
    kn = (const bf16_t*)(p.ws + WS_KNL) + (size_t)(b * 2 + kvh) * 1280 * 64;
    vt = (const bf16_t*)(p.ws + WS_VTL) + (size_t)(b * 2 + kvh) * 64 * 1280;
  } else {
    const int i2 = item - 512;
    b = i2 >> 4; hq = (i2 >> 1) & 7; qt = i2 & 1; Lk = 256; qtok0 = b * 256 + qt * 128;
    const int kvh = hq >> 2;
    kn = (const bf16_t*)(p.ws + WS_KNC) + (size_t)(b * 2 + kvh) * 256 * 64;
    vt = (const bf16_t*)(p.ws + WS_VTC) + (size_t)(b * 2 + kvh) * 64 * 256;
  }
  const bf16_t* qn = (const bf16_t*)(p.ws + WS_QN);
  bf16_t* am = (bf16_t*)(p.ws + WS_HBUF);
  char* Ks = smem; char* Vs = smem + 8192;
  bf16x8 qf[2][2];
#pragma unroll
  for (int qs = 0; qs < 2; ++qs)
#pragma unroll
    for (int ks = 0; ks < 2; ++ks)
      qf[qs][ks] = *(const bf16x8*)(qn + (size_t)(qtok0 + wave * 32 + qs * 16 + l15) * 512 + hq * 64 + ks * 32 + q4 * 8);
  f32x4 o[2][4];
#pragma unroll
  for (int qs = 0; qs < 2; ++qs)
#pragma unroll
    for (int db = 0; db < 4; ++db) o[qs][db] = (f32x4){0.f, 0.f, 0.f, 0.f};
  float mrun[2] = {-1e30f, -1e30f}, lsum[2] = {0.f, 0.f};
  u32x4 rk[2], rv[2];
  const int nkt = Lk >> 6;
#pragma unroll
  for (int i = 0; i < 2; ++i) {
    const int idx = tid + 256 * i, r = idx >> 3, ch = idx & 7;
    rk[i] = *(const u32x4*)(kn + (size_t)r * 64 + ch * 8);
    rv[i] = *(const u32x4*)(vt + (size_t)r * Lk + ch * 8);
  }
  for (int kt = 0; kt < nkt; ++kt) {
    __syncthreads();
#pragma unroll
    for (int i = 0; i < 2; ++i) {
      const int idx = tid + 256 * i, r = idx >> 3, ch = idx & 7;
      *(u32x4*)(Ks + r * 128 + ((ch ^ (r & 7)) << 4)) = rk[i];
      *(u32x4*)(Vs + r * 144 + ch * 16) = rv[i];
    }
    __syncthreads();
    if (kt + 1 < nkt) {
#pragma unroll
      for (int i = 0; i < 2; ++i) {
        const int idx = tid + 256 * i, r = idx >> 3, ch = idx & 7;
        rk[i] = *(const u32x4*)(kn + (size_t)((kt + 1) * 64 + r) * 64 + ch * 8);
        rv[i] = *(const u32x4*)(vt + (size_t)r * Lk + (kt + 1) * 64 + ch * 8);
      }
    }
    f32x4 s[2][4];
#pragma unroll
    for (int qs = 0; qs < 2; ++qs)
#pragma unroll
      for (int kb = 0; kb < 4; ++kb) s[qs][kb] = (f32x4){0.f, 0.f, 0.f, 0.f};
#pragma unroll
    for (int ks = 0; ks < 2; ++ks)
#pragma unroll
      for (int kb = 0; kb < 4; ++kb) {
        const int key = kb * 16 + l15, ch = ks * 4 + q4;
        const bf16x8 kf = *(const bf16x8*)(Ks + key * 128 + ((ch ^ (key & 7)) << 4));
#pragma unroll
        for (int qs = 0; qs < 2; ++qs) s[qs][kb] = __builtin_amdgcn_mfma_f32_16x16x32_bf16(kf, qf[qs][ks], s[qs][kb], 0, 0, 0);
      }
#pragma unroll
    for (int qs = 0; qs < 2; ++qs) {
      float mx = -1e30f;
#pragma unroll
      for (int kb = 0; kb < 4; ++kb)
#pragma unroll
        for (int j = 0; j < 4; ++j) mx = fmaxf(mx, s[qs][kb][j]);
      mx = fmaxf(mx, __shfl_xor(mx, 16));
      mx = fmaxf(mx, __shfl_xor(mx, 32));
      const float mn = fmaxf(mrun[qs], mx);
      const float alpha = __builtin_amdgcn_exp2f(mrun[qs] - mn);
      mrun[qs] = mn;
      float ps = 0.f;
#pragma unroll
      for (int kb = 0; kb < 4; ++kb)
#pragma unroll
        for (int j = 0; j < 4; ++j) { const float pv = __builtin_amdgcn_exp2f(s[qs][kb][j] - mn); s[qs][kb][j] = pv; ps += pv; }
      lsum[qs] = lsum[qs] * alpha + ps;
#pragma unroll
      for (int db = 0; db < 4; ++db) o[qs][db] *= alpha;
    }
#pragma unroll
    for (int s2 = 0; s2 < 2; ++s2) {
      bf16x8 pf[2];
#pragma unroll
      for (int qs = 0; qs < 2; ++qs) {
        union { uint4 u; bf16x8 v; } cv;
        cv.u = make_uint4(pack2(s[qs][2 * s2][0], s[qs][2 * s2][1]), pack2(s[qs][2 * s2][2], s[qs][2 * s2][3]),
                          pack2(s[qs][2 * s2 + 1][0], s[qs][2 * s2 + 1][1]), pack2(s[qs][2 * s2 + 1][2], s[qs][2 * s2 + 1][3]));
        pf[qs] = cv.v;
      }
#pragma unroll
      for (int db = 0; db < 4; ++db) {
        const char* vp = Vs + (db * 16 + l15) * 144 + (s2 * 32 + q4 * 4) * 2;
        const uint2 lo = *(const uint2*)vp;
        const uint2 hi = *(const uint2*)(vp + 32);
        union { uint4 u; bf16x8 v; } cv;
        cv.u = make_uint4(lo.x, lo.y, hi.x, hi.y);
#pragma unroll
        for (int qs = 0; qs < 2; ++qs) o[qs][db] = __builtin_amdgcn_mfma_f32_16x16x32_bf16(cv.v, pf[qs], o[qs][db], 0, 0, 0);
      }
    }
  }
#pragma unroll
  for (int qs = 0; qs < 2; ++qs) {
    float l = lsum[qs];
    l += __shfl_xor(l, 16);
    l += __shfl_xor(l, 32);
    const float inv = 1.f / l;
    const size_t tok = (size_t)(qtok0 + wave * 32 + qs * 16 + l15);
#pragma unroll
    for (int db = 0; db < 4; ++db) {
      const f32x4 v = o[qs][db] * inv;
      *(uint2*)(am + tok * DM + 512 + hq * 64 + db * 16 + q4 * 4) = make_uint2(pack2(v[0], v[1]), pack2(v[2], v[3]));
    }
  }
  __syncthreads();
}

__device__ void phase4(const Params& p, char* smem, unsigned* bar, volatile LAS unsigned* qslot, int rep) {
  unsigned* q0 = &bar[XB_QUEUE + 256 * rep];
  for (;;) {
    __syncthreads();
    if (threadIdx.x == 0) *qslot = xb_add(q0, 1u);
    __syncthreads();
    const unsigned item = *qslot;
    if (item >= 384u) break;
    scan_chunked(p, (int)item, smem);
  }
  for (;;) {
    __syncthreads();
    if (threadIdx.x == 0) *qslot = xb_add(q0 + 64, 1u);
    __syncthreads();
    const unsigned item = *qslot;
    if (item >= 768u) break;
    attn_item(p, (int)item, smem);
  }
  if (rep == 0) {
    for (;;) {
      __syncthreads();
      if (threadIdx.x == 0) *qslot = xb_add(q0 + 128, 1u);
      __syncthreads();
      const unsigned item = *qslot;
      if (item >= 360u) break;
      if (item < 64u) { __syncthreads(); adaln_item(p, 32 + (int)item, -1, smem); }
      else for (int j = 0; j < 8; ++j) { __syncthreads(); transpose_item(p, 640 + ((int)item - 64) * 8 + j, smem); }
    }
  }
}

__device__ __forceinline__ float half_sum(float v) {
  v += __int_as_float(__builtin_amdgcn_mov_dpp(__float_as_int(v), 0xB1, 0xF, 0xF, true));
  v += __int_as_float(__builtin_amdgcn_mov_dpp(__float_as_int(v), 0x4E, 0xF, 0xF, true));
  v += __int_as_float(__builtin_amdgcn_mov_dpp(__float_as_int(v), 0x141, 0xF, 0xF, true));
  v += __int_as_float(__builtin_amdgcn_mov_dpp(__float_as_int(v), 0x140, 0xF, 0xF, true));
  v += __shfl_xor(v, 16);
  return v;
}
__device__ void phase5(const Params& p) {
  const int lane = threadIdx.x & 63, wave = threadIdx.x >> 6;
  const int hh = lane >> 5, l2 = (lane & 31) * 2;
  const bf16_t* pb = (const bf16_t*)(p.ws + WS_PB);
  const bf16_t* lb = (const bf16_t*)(p.ws + WS_LB);
  const bf16_t* yd0 = (const bf16_t*)(p.ws + WS_YD);
  const bf16_t* yd1 = yd0 + (size_t)T_ALL * 512;
  bf16_t* am = (bf16_t*)(p.ws + WS_HBUF);
  for (int it = blockIdx.x; it < T_ALL / 4; it += gridDim.x) {
    const int t = it * 4 + wave;
    const bf16_t* prow = pb + (size_t)t * DIN;
    const bf16_t* lrow = lb + (size_t)t * DIN;
#pragma unroll 2
    for (int hp = 0; hp < 4; ++hp) {
      const int c = (hp * 2 + hh) * 64 + l2;
      const unsigned y0 = *(const unsigned*)(yd0 + (size_t)t * 512 + c), y1 = *(const unsigned*)(yd1 + (size_t)t * 512 + c);
      const unsigned ur = *(const unsigned*)(prow + c), uk = *(const unsigned*)(prow + 512 + c), uv = *(const unsigned*)(prow + 1024 + c);
      const unsigned ua0 = *(const unsigned*)(lrow + 1024 + c), ua1 = *(const unsigned*)(lrow + 1536 + c), ug = *(const unsigned*)(lrow + 2048 + c);
      const float2 gw = *(const float2*)(p.gn_w + c), gb = *(const float2*)(p.gn_b + c), ka = *(const float2*)(p.k_a + c), rk = *(const float2*)(p.r_k + c);
      const float ya = bflo(y0) + bflo(y1), yb = bfhi(y0) + bfhi(y1);
      const float mu = half_sum(ya + yb) * (1.f / 64.f);
      const float da = ya - mu, db = yb - mu;
      const float var = half_sum(da * da + db * db) * (1.f / 64.f);
      const float rs = rsqrtf(var + 64e-5f);
      const float kdsa = bflo(uk) * (2.f + (bflo(ua0) + bflo(ua1) - 2.f) * ka.x);
      const float kdsb = bfhi(uk) * (2.f + (bfhi(ua0) + bfhi(ua1) - 2.f) * ka.y);
      const float dot = half_sum(bflo(ur) * kdsa * rk.x + bfhi(ur) * kdsb * rk.y);
      const float oa = (da * rs * gw.x + gb.x + dot * bflo(uv)) * bflo(ug);
      const float ob = (db * rs * gw.y + gb.y + dot * bfhi(uv)) * bfhi(ug);
      *(unsigned*)(am + (size_t)t * DM + c) = pack2(oa, ob);
    }
  }
}

__device__ void phase6(const Params& p, char* smem) {
  const bf16_t* A = (const bf16_t*)(p.ws + WS_HBUF);
  const bf16_t* B = (const bf16_t*)(p.ws + WS_WTOUT);
  bf16_t* mix = (bf16_t*)(p.ws + WS_MIX);
  int mt, nt;
  bool have = xcd_tile(0, 8, mt, nt), pre = false;
  for (int it = 0; have; ++it) {
    int mt2 = 0, nt2 = 0;
    const bool have2 = xcd_tile(it + 1, 8, mt2, nt2);
    const bf16_t* nA_ = have2 ? (A + (size_t)mt2 * 192 * DM) : nullptr;
    const bf16_t* nB_ = have2 ? (B + (size_t)nt2 * 128 * DM) : nullptr;
    gemm_tile(A + (size_t)mt * 192 * DM, DM, B + (size_t)nt * 128 * DM, DM, DM, smem,
              [&](int ml, int nl, f32x4 a, f32x4 b2) { *(u32x4*)(mix + (size_t)(mt * 192 + ml) * DM + nt * 128 + nl) = (u32x4){pack2(a[0], a[1]), pack2(a[2], a[3]), pack2(b2[0], b2[1]), pack2(b2[2], b2[3])}; }, pre, nA_, nB_);
    pre = have2; mt = mt2; nt = nt2; have = have2;
  }
}
__device__ void phase8(const Params& p, char* smem) {
  const bf16_t* A = (const bf16_t*)(p.ws + WS_HBUF);
  const bf16_t* B = (const bf16_t*)(p.ws + WS_WTUP);
  bf16_t* u = (bf16_t*)(p.ws + WS_U);
  int mt, nt;
  bool have = xcd_tile(0, 44, mt, nt), pre = false;
  for (int it = 0; have; ++it) {
    int mt2 = 0, nt2 = 0;
    const bool have2 = xcd_tile(it + 1, 44, mt2, nt2);
    const bf16_t* nA_ = have2 ? (A + (size_t)mt2 * 192 * DM) : nullptr;
    const bf16_t* nB_ = have2 ? (B + (size_t)nt2 * 128 * DM) : nullptr;
    gemm_tile(A + (size_t)mt * 192 * DM, DM, B + (size_t)nt * 128 * DM, DM, DM, smem,
              [&](int ml, int nl, f32x4 a, f32x4 b2) {
                *(u32x4*)(u + (size_t)(mt * 192 + ml) * DFF2 + nt * 128 + nl) = (u32x4){pack2(a[0], a[1]), pack2(a[2], a[3]), pack2(b2[0], b2[1]), pack2(b2[2], b2[3])};
              }, pre, nA_, nB_);
    pre = have2; mt = mt2; nt = nt2; have = have2;
  }
}
__device__ void phase10(const Params& p, char* smem) {
  const bf16_t* A = (const bf16_t*)(p.ws + WS_ACT);
  const bf16_t* B = (const bf16_t*)(p.ws + WS_WTDN);
  bf16_t* f = (bf16_t*)(p.ws + WS_F);
  int mt, nt;
  bool have = xcd_tile(0, 8, mt, nt), pre = false;
  for (int it = 0; have; ++it) {
    int mt2 = 0, nt2 = 0;
    const bool have2 = xcd_tile(it + 1, 8, mt2, nt2);
    const bf16_t* nA_ = have2 ? (A + (size_t)mt2 * 192 * DFF) : nullptr;
    const bf16_t* nB_ = have2 ? (B + (size_t)nt2 * 128 * DFF) : nullptr;
    gemm_tile(A + (size_t)mt * 192 * DFF, DFF, B + (size_t)nt * 128 * DFF, DFF, DFF, smem,
              [&](int ml, int nl, f32x4 a, f32x4 b2) { *(u32x4*)(f + (size_t)(mt * 192 + ml) * DM + nt * 128 + nl) = (u32x4){pack2(a[0], a[1]), pack2(a[2], a[3]), pack2(b2[0], b2[1]), pack2(b2[2], b2[3])}; }, pre, nA_, nB_);
    pre = have2; mt = mt2; nt = nt2; have = have2;
  }
}

__device__ void phase7(const Params& p) {
  const int lane = threadIdx.x & 63, wave = threadIdx.x >> 6;
  const float* mod = (const float*)(p.ws + WS_MOD);
  const bf16_t* mix = (const bf16_t*)(p.ws + WS_MIX);
  bf16_t* hb = (bf16_t*)(p.ws + WS_HBUF);
  for (int it = blockIdx.x; it < T_ALL / 4; it += gridDim.x) {
    const int t = it * 4 + wave;
    const float* x = xrow(p, t);
    const float* md = mod + modrow(t) * 6144;
    float4 v[4];
    float ss = 0.f;
#pragma unroll
    for (int i = 0; i < 4; ++i) {
      { const uint2 u_ = *(const uint2*)(mix + (size_t)t * DM + (i * 64 + lane) * 4); v[i] = make_float4(bflo(u_.x), bfhi(u_.x), bflo(u_.y), bfhi(u_.y)); }
      ss += v[i].x * v[i].x + v[i].y * v[i].y + v[i].z * v[i].z + v[i].w * v[i].w;
    }
    ss = wave_sum(ss);
    const float rstd = rsqrtf(ss * (1.f / 1024.f) + 1e-6f);
    float ss2 = 0.f;
#pragma unroll
    for (int i = 0; i < 4; ++i) {
      const int c = (i * 64 + lane) * 4;
      const float4 xv = *(const float4*)(x + c);
      const float4 g = *(const float4*)(p.norm_mix_post + c);
      const float4 gt = *(const float4*)(md + 2048 + c);
      v[i].x = xv.x + gt.x * (v[i].x * rstd * g.x);
      v[i].y = xv.y + gt.y * (v[i].y * rstd * g.y);
      v[i].z = xv.z + gt.z * (v[i].z * rstd * g.z);
      v[i].w = xv.w + gt.w * (v[i].w * rstd * g.w);
      *(float4*)(p.out + (size_t)t * DM + c) = v[i];
      ss2 += v[i].x * v[i].x + v[i].y * v[i].y + v[i].z * v[i].z + v[i].w * v[i].w;
    }
    ss2 = wave_sum(ss2);
    const float rstd2 = rsqrtf(ss2 * (1.f / 1024.f) + 1e-6f);
#pragma unroll
    for (int i = 0; i < 4; ++i) {
      const int c = (i * 64 + lane) * 4;
      const float4 g = *(const float4*)(p.norm_ffn_pre + c);
      const float4 sh = *(const float4*)(md + 3072 + c);
      const float4 sc = *(const float4*)(md + 4096 + c);
      const float o0 = v[i].x * rstd2 * g.x * (1.f + sc.x) + sh.x;
      const float o1 = v[i].y * rstd2 * g.y * (1.f + sc.y) + sh.y;
      const float o2 = v[i].z * rstd2 * g.z * (1.f + sc.z) + sh.z;
      const float o3 = v[i].w * rstd2 * g.w * (1.f + sc.w) + sh.w;
      *(uint2*)(hb + (size_t)t * DM + c) = make_uint2(pack2(o0, o1), pack2(o2, o3));
    }
  }
}

__device__ void phase9(const Params& p) {
  const bf16_t* u = (const bf16_t*)(p.ws + WS_U);
  bf16_t* act = (bf16_t*)(p.ws + WS_ACT);
  const int cgi = threadIdx.x & 31, tsub = threadIdx.x >> 5;
  for (int it = blockIdx.x; it < 11 * 192; it += gridDim.x) {
    const int cb = it % 11, tt = it / 11;
    const int cc = (cb * 32 + cgi) * 8;
    const int t0 = tt * 64 + tsub * 8;
    const int L = t0 < T_CTX ? 256 : 1024;
    const int pos0 = t0 < T_CTX ? (t0 & 255) : ((t0 - T_CTX) & 1023);
    float wg[3][8], wv[3][8], bg[8], bv[8];
#pragma unroll
    for (int j = 0; j < 3; ++j) {
      const float4 a0 = *(const float4*)(p.conv_w + j * DFF2 + cc), a1 = *(const float4*)(p.conv_w + j * DFF2 + cc + 4);
      const float4 c0 = *(const float4*)(p.conv_w + j * DFF2 + DFF + cc), c1 = *(const float4*)(p.conv_w + j * DFF2 + DFF + cc + 4);
      wg[j][0] = a0.x; wg[j][1] = a0.y; wg[j][2] = a0.z; wg[j][3] = a0.w; wg[j][4] = a1.x; wg[j][5] = a1.y; wg[j][6] = a1.z; wg[j][7] = a1.w;
      wv[j][0] = c0.x; wv[j][1] = c0.y; wv[j][2] = c0.z; wv[j][3] = c0.w; wv[j][4] = c1.x; wv[j][5] = c1.y; wv[j][6] = c1.z; wv[j][7] = c1.w;
    }
    {
      const float4 a0 = *(const float4*)(p.conv_b + cc), a1 = *(const float4*)(p.conv_b + cc + 4);
      const float4 c0 = *(const float4*)(p.conv_b + DFF + cc), c1 = *(const float4*)(p.conv_b + DFF + cc + 4);
      bg[0] = a0.x; bg[1] = a0.y; bg[2] = a0.z; bg[3] = a0.w; bg[4] = a1.x; bg[5] = a1.y; bg[6] = a1.z; bg[7] = a1.w;
      bv[0] = c0.x; bv[1] = c0.y; bv[2] = c0.z; bv[3] = c0.w; bv[4] = c1.x; bv[5] = c1.y; bv[6] = c1.z; bv[7] = c1.w;
    }
    const bf16_t* ur = u + (size_t)t0 * DFF2 + cc;
    const u32x4 z = (u32x4){0u, 0u, 0u, 0u};
    u32x4 g0 = (pos0 > 0) ? *(const u32x4*)(ur - DFF2) : z;
    u32x4 v0 = (pos0 > 0) ? *(const u32x4*)(ur - DFF2 + DFF) : z;
    u32x4 g1 = *(const u32x4*)(ur);
    u32x4 v1 = *(const u32x4*)(ur + DFF);
#pragma unroll 4
    for (int i = 0; i < 8; ++i) {
      const bool hp = (pos0 + i) < L - 1;
      const u32x4 g2 = hp ? *(const u32x4*)(ur + (size_t)(i + 1) * DFF2) : z;
      const u32x4 v2 = hp ? *(const u32x4*)(ur + (size_t)(i + 1) * DFF2 + DFF) : z;
      unsigned o[4];
#pragma unroll
      for (int e2 = 0; e2 < 4; ++e2) {
        const float ga = bg[2 * e2] + wg[0][2 * e2] * bflo(g0[e2]) + wg[1][2 * e2] * bflo(g1[e2]) + wg[2][2 * e2] * bflo(g2[e2]);
        const float gb = bg[2 * e2 + 1] + wg[0][2 * e2 + 1] * bfhi(g0[e2]) + wg[1][2 * e2 + 1] * bfhi(g1[e2]) + wg[2][2 * e2 + 1] * bfhi(g2[e2]);
        const float va = bv[2 * e2] + wv[0][2 * e2] * bflo(v0[e2]) + wv[1][2 * e2] * bflo(v1[e2]) + wv[2][2 * e2] * bflo(v2[e2]);
        const float vb = bv[2 * e2 + 1] + wv[0][2 * e2 + 1] * bfhi(v0[e2]) + wv[1][2 * e2 + 1] * bfhi(v1[e2]) + wv[2][2 * e2 + 1] * bfhi(v2[e2]);
        o[e2] = pack2(ga * sigmoidf_(ga) * va, gb * sigmoidf_(gb) * vb);
      }
      *(u32x4*)(act + (size_t)(t0 + i) * DFF + cc) = (u32x4){o[0], o[1], o[2], o[3]};
      g0 = g1; g1 = g2; v0 = v1; v1 = v2;
    }
  }
}

__device__ void phase11(const Params& p) {
  const int lane = threadIdx.x & 63, wave = threadIdx.x >> 6;
  const float* mod = (const float*)(p.ws + WS_MOD);
  const bf16_t* f = (const bf16_t*)(p.ws + WS_F);
  for (int it = blockIdx.x; it < T_ALL / 4; it += gridDim.x) {
    const int t = it * 4 + wave;
    const float* md = mod + modrow(t) * 6144;
    float4 v[4];
    float ss = 0.f;
#pragma unroll
    for (int i = 0; i < 4; ++i) {
      { const uint2 u_ = *(const uint2*)(f + (size_t)t * DM + (i * 64 + lane) * 4); v[i] = make_float4(bflo(u_.x), bfhi(u_.x), bflo(u_.y), bfhi(u_.y)); }
      ss += v[i].x * v[i].x + v[i].y * v[i].y + v[i].z * v[i].z + v[i].w * v[i].w;
    }
    ss = wave_sum(ss);
    const float rstd = rsqrtf(ss * (1.f / 1024.f) + 1e-6f);
#pragma unroll
    for (int i = 0; i < 4; ++i) {
      const int c = (i * 64 + lane) * 4;
      float4 xv = *(const float4*)(p.out + (size_t)t * DM + c);
      const float4 g = *(const float4*)(p.norm_ffn_post + c);
      const float4 gt = *(const float4*)(md + 5120 + c);
      xv.x += gt.x * (v[i].x * rstd * g.x);
      xv.y += gt.y * (v[i].y * rstd * g.y);
      xv.z += gt.z * (v[i].z * rstd * g.z);
      xv.w += gt.w * (v[i].w * rstd * g.w);
      *(float4*)(p.out + (size_t)t * DM + c) = xv;
    }
  }
}

#define SMEM_BYTES 81920
__global__ void __launch_bounds__(256, 2) hybrid_fwd(Params p) {
  __shared__ __attribute__((aligned(16))) char smem[SMEM_BYTES];
  __syncthreads();
  unsigned* bar = (unsigned*)(p.ws + WS_BAR);
  XcdBarrier xb = xcd_barrier_post(bar);
  volatile LAS unsigned* qslot = (volatile LAS unsigned*)(smem + SMEM_BYTES - 16);

  const int zr = (int)xb_ld(&bar[8]);
#define RUNPH(N, CALL) { CALL; if (REPP == (N)) { xcd_barrier(xb); for (int r_ = 0; r_ < 1 + zr; ++r_) { CALL; } } }
  RUNPH(0, phase0(p, smem));
  xcd_barrier(xb);
  RUNPH(1, phase1(p));
  xcd_barrier(xb);
  RUNPH(2, phase2(p, smem));
  xcd_barrier(xb);
  phase3(p, smem);
  if (REPP == 31) { xcd_barrier(xb); phase3(p, smem, 1 + zr); }
  if (REPP == 32) { xcd_barrier(xb); phase3(p, smem, 2 + zr); }
  xcd_barrier(xb);
  phase4(p, smem, bar, qslot, 0);
  if (REPP == 4) { xcd_barrier(xb); phase4(p, smem, bar, qslot, 1); }
  xcd_barrier(xb);
  RUNPH(5, phase5(p));
  xcd_barrier(xb);
  RUNPH(6, phase6(p, smem));
  xcd_barrier(xb);
  RUNPH(7, phase7(p));
  xcd_barrier(xb);
  RUNPH(8, phase8(p, smem));
  xcd_barrier(xb);
  RUNPH(9, phase9(p));
  xcd_barrier(xb);
  RUNPH(10, phase10(p, smem));
  xcd_barrier(xb);
  phase11(p);
}

extern "C" void kernel_launch(void* const* d_in, const int* in_sizes, int n_in, void* d_out, int out_size,
                              void* d_ws, size_t ws_size, hipStream_t stream) {
  static int grid_blocks = 0;
  if (!grid_blocks) {
    int dev = 0, cus = 0, per_cu = 0;
    hipGetDevice(&dev);
    hipDeviceGetAttribute(&cus, hipDeviceAttributeMultiprocessorCount, dev);
    hipOccupancyMaxActiveBlocksPerMultiprocessor(&per_cu, hybrid_fwd, 256, 0);
    if (per_cu > 2) per_cu = 2;
    if (per_cu < 1) per_cu = 1;
    grid_blocks = cus * per_cu;
  }
  Params p{};
  const float** pp = (const float**)&p;
  for (int i = 0; i < 31; ++i) pp[i] = (const float*)d_in[i];
  p.out = (float*)d_out;
  p.ws = (char*)d_ws;
  hipMemsetAsync(d_ws, 0, 16384, stream);
  void* args[] = {&p};
  hipError_t e = hipLaunchCooperativeKernel((void*)hybrid_fwd, dim3(grid_blocks), dim3(256), args, 0, stream);
  if (e != hipSuccess) fprintf(stderr, "cooperative launch failed: %s (grid %d)\n", hipGetErrorString(e), grid_blocks);
}
```

```cpp
#include <hip/hip_runtime.h>
#include <stdint.h>
#include <cstdio>

typedef unsigned short bf16_t;
typedef short bf16x8 __attribute__((ext_vector_type(8)));
typedef float f32x4 __attribute__((ext_vector_type(4)));
typedef unsigned u32x4 __attribute__((ext_vector_type(4)));

#ifndef REPP
#define REPP -1
#endif
#define T_CTX 4096
#define T_ALL 12288
#define DM 1024
#define DIN 2560
#define DFF 2816
#define DFF2 5632

#define WS_BAR    0ul
#define WS_MOD    16384ul
#define WS_ROPE   (WS_MOD + 221184ul)
#define WS_WTIN   (WS_ROPE + 262144ul)
#define WS_WTOUT  (WS_WTIN + 5242880ul)
#define WS_WTUP   (WS_WTOUT + 2097152ul)
#define WS_WTDN   (WS_WTUP + 11534336ul)
#define WS_WTLW   (WS_WTDN + 5767168ul)
#define WS_WTLA   (WS_WTLW + 131072ul)
#define WS_WTLG   (WS_WTLA + 131072ul)
#define WS_HBUF   (WS_WTLG + 131072ul)
#define WS_AREA   (WS_HBUF + 25165824ul)
#define WS_PB     (WS_AREA)
#define WS_LB     (WS_PB + 62914560ul)
#define WS_QN     (WS_LB + 62914560ul)
#define WS_KNC    (WS_QN + 12582912ul)
#define WS_KNL    (WS_KNC + 1048576ul)
#define WS_VTC    (WS_KNL + 2621440ul)
#define WS_VTL    (WS_VTC + 1048576ul)
#define WS_YD     (WS_VTL + 2621440ul)
#define WS_RN     (WS_YD + 50331648ul)
#define WS_MODP   (WS_RN + 393216ul)
#define WS_MIX    (WS_AREA)
#define WS_U      (WS_AREA)
#define WS_ACT    (WS_AREA + 138412032ul)
#define WS_F      (WS_AREA)
#define WS_END    (WS_ACT + 69206016ul)
static_assert(WS_END <= 268435456ul, "workspace too large");
static_assert(WS_RN + 393216ul <= 268435456ul, "workspace too large");

#define OUT_CK 12582912ul
#define OUT_CV 13107200ul
#define OUT_ST 13631488ul

struct Params {
  const float *x_prompt, *x_sample, *cache_k, *cache_v, *state_rwkv, *c, *c_ctx, *w_mod, *b_mod,
      *norm_mix_pre, *norm_mix_post, *norm_ffn_pre, *norm_ffn_post, *w_in, *w0, *w_up, *a0, *a_up, *g_up,
      *k_k, *k_a, *r_k, *gn_w, *gn_b, *q_norm, *k_norm, *w_out, *ffn_up, *conv_w, *conv_b, *ffn_down;
  float* out;
  char* ws;
};

#define XB_TMO      128
#define XB_XCNT(j)  (256  + 64 * (j))
#define XB_XSUB(j)  (1280 + 64 * (j))
#define XB_XGEN(j)  (2304 + 64 * (j))
#define XB_TOP      3328
#define XB_TOPGEN   3392
#define XCD_BAR_WORDS 3456
#define XB_QUEUE    3520
#define XB_SPIN_CAP (1u << 22)
#define LAS __attribute__((address_space(3)))

__device__ __forceinline__ unsigned xb_ld(unsigned* p)              { return __hip_atomic_load(p, __ATOMIC_RELAXED, __HIP_MEMORY_SCOPE_AGENT); }
__device__ __forceinline__ unsigned xb_add(unsigned* p, unsigned v) { return __hip_atomic_fetch_add(p, v, __ATOMIC_RELAXED, __HIP_MEMORY_SCOPE_AGENT); }
__device__ __forceinline__ unsigned xb_xcc_id() { return (unsigned)__builtin_amdgcn_s_getreg((3 << 11) | 20) & 0xFu; }
#define XB_SPIN(cond, bar) do { unsigned _sp = 0; while (cond) { __builtin_amdgcn_s_sleep(1); \
    if ((++_sp & 255u) == 0u) { if (xb_ld(&(bar)[XB_TMO])) break; if (_sp > XB_SPIN_CAP) { atomicAdd(&(bar)[XB_TMO], 1u); break; } } } } while (0)

struct XcdBarrier { unsigned* bar; unsigned x; unsigned nloc, nx; };

__device__ __forceinline__ XcdBarrier xcd_barrier_post(unsigned* bar) {
  XcdBarrier b; b.bar = bar; b.x = xb_xcc_id(); b.nloc = 0u; b.nx = 0u;
  if (threadIdx.x == 0) (void)xb_add(&bar[XB_XCNT(b.x)], 1u);
  return b;
}
__device__ __forceinline__ void xcd_barrier_complete(unsigned* bar, unsigned x, unsigned& nloc, unsigned& nx) {
  const unsigned G = gridDim.x * gridDim.y * gridDim.z;
  unsigned sum, cnt, mine, sp = 0u;
  for (;;) {
    sum = 0u; cnt = 0u; mine = 0u;
#pragma unroll
    for (unsigned j = 0; j < 16; ++j) { const unsigned c = xb_ld(&bar[XB_XCNT(j)]); sum += c; cnt += (c > 0u) ? 1u : 0u; mine = (j == x) ? c : mine; }
    if (sum == G) break;
    __builtin_amdgcn_s_sleep(1);
    if ((++sp & 255u) == 0u) { if (xb_ld(&bar[XB_TMO])) break; if (sp > XB_SPIN_CAP) { atomicAdd(&bar[XB_TMO], 1u); break; } }
  }
  nloc = mine > 0u ? mine : 1u; nx = cnt > 0u ? cnt : 1u;
}
__device__ __forceinline__ void xcd_barrier(XcdBarrier& b) {
  asm volatile("s_waitcnt vmcnt(0)" ::: "memory");
  __syncthreads();
  if (threadIdx.x == 0) {
    unsigned* bar = b.bar;
    __builtin_amdgcn_s_waitcnt(0);
    unsigned nloc = b.nloc, nx = b.nx;
    if (nloc == 0u) { xcd_barrier_complete(bar, b.x, nloc, nx); b.nloc = nloc; b.nx = nx; }
    const unsigned old = xb_add(&bar[XB_XSUB(b.x)], 1u);
    const unsigned gen = old / nloc;
    if (old + 1u == (gen + 1u) * nloc) {
      __builtin_amdgcn_fence(__ATOMIC_RELEASE, "agent");
      asm volatile("s_waitcnt vmcnt(0)" ::: "memory");
      const unsigned og = xb_add(&bar[XB_TOP], 1u);
      const unsigned tg = og / nx;
      if (og + 1u == (tg + 1u) * nx) xb_add(&bar[XB_TOPGEN], 1u);
      else XB_SPIN(xb_ld(&bar[XB_TOPGEN]) == tg, bar);
      __builtin_amdgcn_fence(__ATOMIC_ACQUIRE, "agent");
      xb_add(&bar[XB_XGEN(b.x)], 1u);
      asm volatile("s_waitcnt vmcnt(0)" ::: "memory");
    } else {
      XB_SPIN(xb_ld(&bar[XB_XGEN(b.x)]) == gen, bar);
      __builtin_amdgcn_fence(__ATOMIC_ACQUIRE, "agent");
      asm volatile("s_waitcnt vmcnt(0)" ::: "memory");
    }
  }
  __syncthreads();
}

__device__ __forceinline__ unsigned f2bf(float f) { unsigned u = __float_as_uint(f); return (u + 0x7fffu + ((u >> 16) & 1u)) >> 16; }
typedef __bf16 bf16x2_t __attribute__((ext_vector_type(2)));
typedef float f32x2_t __attribute__((ext_vector_type(2)));
__device__ __forceinline__ unsigned pack2(float a, float b) {
  const f32x2_t v = {a, b};
  return __builtin_bit_cast(unsigned, __builtin_convertvector(v, bf16x2_t));
}
__device__ __forceinline__ float bf2f(unsigned b) { return __uint_as_float(b << 16); }
__device__ __forceinline__ float bflo(unsigned u) { return __uint_as_float(u << 16); }
__device__ __forceinline__ float bfhi(unsigned u) { return __uint_as_float(u & 0xffff0000u); }
__device__ __forceinline__ float wave_sum(float v) {
  v += __int_as_float(__builtin_amdgcn_mov_dpp(__float_as_int(v), 0xB1, 0xF, 0xF, true));
  v += __int_as_float(__builtin_amdgcn_mov_dpp(__float_as_int(v), 0x4E, 0xF, 0xF, true));
  v += __int_as_float(__builtin_amdgcn_mov_dpp(__float_as_int(v), 0x141, 0xF, 0xF, true));
  v += __int_as_float(__builtin_amdgcn_mov_dpp(__float_as_int(v), 0x140, 0xF, 0xF, true));
  const float a = __int_as_float(__builtin_amdgcn_readlane(__float_as_int(v), 0));
  const float b = __int_as_float(__builtin_amdgcn_readlane(__float_as_int(v), 16));
  const float c = __int_as_float(__builtin_amdgcn_readlane(__float_as_int(v), 32));
  const float d = __int_as_float(__builtin_amdgcn_readlane(__float_as_int(v), 48));
  return (a + b) + (c + d);
}
__device__ __forceinline__ float quad_sum(float x) {
  x += __int_as_float(__builtin_amdgcn_mov_dpp(__float_as_int(x), 0xB1, 0xF, 0xF, true));
  x += __int_as_float(__builtin_amdgcn_mov_dpp(__float_as_int(x), 0x4E, 0xF, 0xF, true));
  return x;
}
__device__ __forceinline__ float sigmoidf_(float x) { return 1.f / (1.f + __expf(-x)); }
__device__ __forceinline__ const float* xrow(const Params& p, int t) {
  return t < T_CTX ? p.x_prompt + (size_t)t * DM : p.x_sample + (size_t)(t - T_CTX) * DM;
}
__device__ __forceinline__ int modrow(int t) { return t < T_CTX ? 0 : 1 + ((t - T_CTX) >> 10); }

__device__ __forceinline__ unsigned lds_addr(const void* p) { return (unsigned)(size_t)(const LAS char*)p; }
template <int OFF>
__device__ __forceinline__ bf16x8 lds_read128(unsigned addr) {
  bf16x8 v;
  asm volatile("ds_read_b128 %0, %1 offset:%2" : "=v"(v) : "v"(addr), "n"(OFF));
  return v;
}
template <int BUFOFF>
__device__ __forceinline__ void gemm_kstep128(const unsigned (&aaddr)[2], const unsigned (&baddr)[2], f32x4 (&acc)[4][4]) {
  bf16x8 a0[4], b0[4], a1[4], b1[4];
  a0[0] = lds_read128<BUFOFF + 0>(aaddr[0]);    b0[0] = lds_read128<BUFOFF + 16384 + 0>(baddr[0]);
  a0[1] = lds_read128<BUFOFF + 2048>(aaddr[0]); b0[1] = lds_read128<BUFOFF + 16384 + 2048>(baddr[0]);
  a0[2] = lds_read128<BUFOFF + 4096>(aaddr[0]); b0[2] = lds_read128<BUFOFF + 16384 + 4096>(baddr[0]);
  a0[3] = lds_read128<BUFOFF + 6144>(aaddr[0]); b0[3] = lds_read128<BUFOFF + 16384 + 6144>(baddr[0]);
  a1[0] = lds_read128<BUFOFF + 0>(aaddr[1]);    b1[0] = lds_read128<BUFOFF + 16384 + 0>(baddr[1]);
  a1[1] = lds_read128<BUFOFF + 2048>(aaddr[1]); b1[1] = lds_read128<BUFOFF + 16384 + 2048>(baddr[1]);
  a1[2] = lds_read128<BUFOFF + 4096>(aaddr[1]); b1[2] = lds_read128<BUFOFF + 16384 + 4096>(baddr[1]);
  a1[3] = lds_read128<BUFOFF + 6144>(aaddr[1]); b1[3] = lds_read128<BUFOFF + 16384 + 6144>(baddr[1]);
  asm volatile("s_waitcnt lgkmcnt(8)" : "+v"(a0[0]), "+v"(a0[1]), "+v"(a0[2]), "+v"(a0[3]), "+v"(b0[0]), "+v"(b0[1]), "+v"(b0[2]), "+v"(b0[3]));
#pragma unroll
  for (int ni = 0; ni < 4; ++ni)
#pragma unroll
    for (int mi = 0; mi < 4; ++mi)
      acc[ni][mi] = __builtin_amdgcn_mfma_f32_16x16x32_bf16(b0[ni], a0[mi], acc[ni][mi], 0, 0, 0);
  __builtin_amdgcn_sched_barrier(0);
  asm volatile("s_waitcnt lgkmcnt(0)" : "+v"(a1[0]), "+v"(a1[1]), "+v"(a1[2]), "+v"(a1[3]), "+v"(b1[0]), "+v"(b1[1]), "+v"(b1[2]), "+v"(b1[3]));
#pragma unroll
  for (int ni = 0; ni < 4; ++ni)
#pragma unroll
    for (int mi = 0; mi < 4; ++mi)
      acc[ni][mi] = __builtin_amdgcn_mfma_f32_16x16x32_bf16(b1[ni], a1[mi], acc[ni][mi], 0, 0, 0);
  __builtin_amdgcn_sched_barrier(0);
}

template <int STOFF>
__device__ __forceinline__ void gemm_kstep(const unsigned (&aaddr)[2], const unsigned (&baddr)[2], f32x4 (&acc)[4][6]) {
#pragma unroll
  for (int ks = 0; ks < 2; ++ks) {
    bf16x8 a[3], b[4];
    a[0] = lds_read128<STOFF + 0>(aaddr[ks]);     b[0] = lds_read128<STOFF + 0>(baddr[ks]);
    b[1] = lds_read128<STOFF + 2048>(baddr[ks]);  b[2] = lds_read128<STOFF + 4096>(baddr[ks]);
    b[3] = lds_read128<STOFF + 6144>(baddr[ks]);
    a[1] = lds_read128<STOFF + 2048>(aaddr[ks]);  a[2] = lds_read128<STOFF + 4096>(aaddr[ks]);
    asm volatile("s_waitcnt lgkmcnt(2)" : "+v"(a[0]), "+v"(b[0]), "+v"(b[1]), "+v"(b[2]), "+v"(b[3]));
    __builtin_amdgcn_s_setprio(1);
#pragma unroll
    for (int ni = 0; ni < 4; ++ni) acc[ni][0] = __builtin_amdgcn_mfma_f32_16x16x32_bf16(b[ni], a[0], acc[ni][0], 0, 0, 0);
    __builtin_amdgcn_sched_barrier(0);
    a[0] = lds_read128<STOFF + 6144>(aaddr[ks]);
    asm volatile("s_waitcnt lgkmcnt(2)" : "+v"(a[1]));
#pragma unroll
    for (int ni = 0; ni < 4; ++ni) acc[ni][1] = __builtin_amdgcn_mfma_f32_16x16x32_bf16(b[ni], a[1], acc[ni][1], 0, 0, 0);
    __builtin_amdgcn_sched_barrier(0);
    a[1] = lds_read128<STOFF + 8192>(aaddr[ks]);
    asm volatile("s_waitcnt lgkmcnt(2)" : "+v"(a[2]));
#pragma unroll
    for (int ni = 0; ni < 4; ++ni) acc[ni][2] = __builtin_amdgcn_mfma_f32_16x16x32_bf16(b[ni], a[2], acc[ni][2], 0, 0, 0);
    __builtin_amdgcn_sched_barrier(0);
    a[2] = lds_read128<STOFF + 10240>(aaddr[ks]);
    asm volatile("s_waitcnt lgkmcnt(2)" : "+v"(a[0]));
#pragma unroll
    for (int ni = 0; ni < 4; ++ni) acc[ni][3] = __builtin_amdgcn_mfma_f32_16x16x32_bf16(b[ni], a[0], acc[ni][3], 0, 0, 0);
    __builtin_amdgcn_sched_barrier(0);
    asm volatile("s_waitcnt lgkmcnt(1)" : "+v"(a[1]));
#pragma unroll
    for (int ni = 0; ni < 4; ++ni) acc[ni][4] = __builtin_amdgcn_mfma_f32_16x16x32_bf16(b[ni], a[1], acc[ni][4], 0, 0, 0);
    __builtin_amdgcn_sched_barrier(0);
    asm volatile("s_waitcnt lgkmcnt(0)" : "+v"(a[2]));
#pragma unroll
    for (int ni = 0; ni < 4; ++ni) acc[ni][5] = __builtin_amdgcn_mfma_f32_16x16x32_bf16(b[ni], a[2], acc[ni][5], 0, 0, 0);
    __builtin_amdgcn_s_setprio(0);
    __builtin_amdgcn_sched_barrier(0);
  }
}

template <class Epi>
__device__ __forceinline__ void gemm_tile(const bf16_t* __restrict__ A, int lda, const bf16_t* __restrict__ B, int ldb, int K,
                                          char* smem, Epi&& epi, bool prestaged = false, const bf16_t* nA = nullptr, const bf16_t* nB = nullptr) {
  const int tid = threadIdx.x, lane = tid & 63, wave = tid >> 6;
  const int wm = wave >> 1, wn = wave & 1;
  const int l15 = lane & 15, q4 = lane >> 4;
  f32x4 acc[4][6];
#pragma unroll
  for (int i = 0; i < 4; ++i)
#pragma unroll
    for (int j = 0; j < 6; ++j) acc[i][j] = (f32x4){0.f, 0.f, 0.f, 0.f};
  const int lrow = tid >> 3, lch = (tid & 7) ^ (lrow & 7);
  const int prow = ((lrow >> 2) & 3) * 8 + (lrow >> 4) * 4 + (lrow & 3);
  const bf16_t* ap = A + (size_t)lrow * lda + lch * 8;
  const bf16_t* bp = B + (size_t)prow * ldb + lch * 8;
  const size_t lda32 = (size_t)32 * lda, ldb32 = (size_t)32 * ldb;
  const int nk = K >> 6;
  unsigned aaddr[2], baddr[2];
  const unsigned sbase = lds_addr(smem);
#pragma unroll
  for (int ks = 0; ks < 2; ++ks) {
    const int ch = ks * 4 + q4;
    aaddr[ks] = sbase + (wm * 96 + l15) * 128 + ((ch ^ (l15 & 7)) << 4);
    baddr[ks] = sbase + 24576 + (wn * 64 + l15) * 128 + ((ch ^ (l15 & 7)) << 4);
  }
#define GEMM_STAGE(BUF, K0) { _Pragma("unroll") for (int i = 0; i < 6; ++i) \
    __builtin_amdgcn_global_load_lds((const unsigned*)(ap + i * lda32 + (K0)), (LAS unsigned*)(smem + (BUF) * 40960 + i * 4096 + wave * 1024), 16, 0, 0); \
    _Pragma("unroll") for (int i = 0; i < 4; ++i) \
    __builtin_amdgcn_global_load_lds((const unsigned*)(bp + i * ldb32 + (K0)), (LAS unsigned*)(smem + (BUF) * 40960 + 24576 + i * 4096 + wave * 1024), 16, 0, 0); }
  if (!prestaged) {
    __syncthreads();
    GEMM_STAGE(0, 0);
  }
  for (int kt = 0; kt < nk; kt += 2) {
    asm volatile("s_waitcnt vmcnt(0)" ::: "memory");
    __syncthreads();
    if (kt + 1 < nk) GEMM_STAGE(1, (kt + 1) << 6);
    gemm_kstep<0>(aaddr, baddr, acc);
    if (kt + 1 < nk) {
      asm volatile("s_waitcnt vmcnt(0)" ::: "memory");
      __syncthreads();
      if (kt + 2 < nk) { GEMM_STAGE(0, (kt + 2) << 6); }
      else if (nA != nullptr) {
        const bf16_t* nap = nA + (size_t)lrow * lda + lch * 8;
        const bf16_t* nbp = nB + (size_t)prow * ldb + lch * 8;
#pragma unroll
        for (int i = 0; i < 6; ++i)
          __builtin_amdgcn_global_load_lds((const unsigned*)(nap + i * lda32), (LAS unsigned*)(smem + i * 4096 + wave * 1024), 16, 0, 0);
#pragma unroll
        for (int i = 0; i < 4; ++i)
          __builtin_amdgcn_global_load_lds((const unsigned*)(nbp + i * ldb32), (LAS unsigned*)(smem + 24576 + i * 4096 + wave * 1024), 16, 0, 0);
      }
      gemm_kstep<40960>(aaddr, baddr, acc);
    }
  }
#pragma unroll
  for (int np = 0; np < 2; ++np)
#pragma unroll
    for (int mi = 0; mi < 6; ++mi)
      epi(wm * 96 + mi * 16 + l15, wn * 64 + np * 32 + q4 * 8, acc[2 * np][mi], acc[2 * np + 1][mi]);
}

__device__ __forceinline__ bool xcd_tile(int it, int NT, int& mt, int& nt) {
  const int per = (int)(gridDim.x >> 3);
  const int x = blockIdx.x & 7, slot = blockIdx.x >> 3;
  if ((gridDim.x & 7) != 0) {
    const int tile = blockIdx.x + it * gridDim.x;
    if (tile >= 64 * NT) return false;
    mt = tile / NT; nt = tile - mt * NT; return true;
  }
  const int q = slot + it * per;
  if (q >= 8 * NT) return false;
  const int g = q / (4 * NT), r = q - g * 4 * NT;
  nt = r >> 2; mt = 8 * x + 4 * g + (r & 3);
  return true;
}

__device__ void adaln_item(const Params& p, int cb, int kq, char* smem) {
  const int tid = threadIdx.x, lane = tid & 63, wave = tid >> 6;
  float* s_act = (float*)smem;
  float* s_red = s_act + 9 * 1024;
  for (int i = tid; i < 9 * 1024; i += 256) {
    const int b = i >> 10, k = i & 1023;
    const float cv = (b == 0) ? p.c_ctx[k] : p.c[(b - 1) * 1024 + k];
    s_act[i] = cv / (1.f + __expf(-cv));
  }
  __syncthreads();
  const int c0 = cb * 64;
  float acc[9];
#pragma unroll
  for (int b = 0; b < 9; ++b) acc[b] = 0.f;
  const int kbase = (kq < 0) ? wave * 256 : kq * 256 + wave * 64;
  const int klen = (kq < 0) ? 256 : 64;
  const float* wp = p.w_mod + (size_t)kbase * 6144 + c0 + lane;
#pragma unroll 2
  for (int k = 0; k < klen; k += 16) {
    float wv[16];
#pragma unroll
    for (int j = 0; j < 16; ++j) wv[j] = wp[(size_t)(k + j) * 6144];
#pragma unroll
    for (int b = 0; b < 9; ++b) {
#pragma unroll
      for (int j4 = 0; j4 < 4; ++j4) {
        const float4 a = *(const float4*)&s_act[b * 1024 + kbase + k + j4 * 4];
        acc[b] += a.x * wv[j4 * 4] + a.y * wv[j4 * 4 + 1] + a.z * wv[j4 * 4 + 2] + a.w * wv[j4 * 4 + 3];
      }
    }
  }
#pragma unroll
  for (int b = 0; b < 9; ++b) s_red[(wave * 9 + b) * 64 + lane] = acc[b];
  __syncthreads();
  float* mod = (float*)(p.ws + WS_MOD);
  float* modp = (float*)(p.ws + WS_MODP);
  for (int i = tid; i < 9 * 64; i += 256) {
    const int b = i >> 6, l = i & 63;
    const float s = s_red[(0 * 9 + b) * 64 + l] + s_red[(1 * 9 + b) * 64 + l] + s_red[(2 * 9 + b) * 64 + l] + s_red[(3 * 9 + b) * 64 + l];
    if (kq < 0) mod[b * 6144 + c0 + l] = s + p.b_mod[c0 + l];
    else modp[(kq * 9 + b) * 2048 + c0 + l] = s + (kq == 0 ? p.b_mod[c0 + l] : 0.f);
  }
}

__device__ void transpose_tile(const float* __restrict__ W, int N, bf16_t* __restrict__ Wt, int ldt, int k0, int n0, char* smem) {
  const int tid = threadIdx.x;
  float* tile = (float*)smem;
#pragma unroll
  for (int r = 0; r < 4; ++r) {
    const int i = (tid >> 4) + 16 * r, j = (tid & 15) * 4;
    const float4 v = *(const float4*)(W + (size_t)(k0 + i) * N + n0 + j);
    tile[i * 65 + j + 0] = v.x; tile[i * 65 + j + 1] = v.y; tile[i * 65 + j + 2] = v.z; tile[i * 65 + j + 3] = v.w;
  }
  __syncthreads();
  const int n = tid >> 2, ks = (tid & 3) * 16;
  unsigned o[8];
#pragma unroll
  for (int e = 0; e < 8; ++e) o[e] = pack2(tile[(ks + 2 * e) * 65 + n], tile[(ks + 2 * e + 1) * 65 + n]);
  uint4* dst = (uint4*)(Wt + (size_t)(n0 + n) * ldt + k0 + ks);
  dst[0] = make_uint4(o[0], o[1], o[2], o[3]);
  dst[1] = make_uint4(o[4], o[5], o[6], o[7]);
}

__device__ void transpose_item(const Params& p, int idx, char* smem) {
  const float* W; int K, N; bf16_t* Wt; int ntn;
  if (idx < 640) { W = p.w_in; K = 1024; N = 2560; Wt = (bf16_t*)(p.ws + WS_WTIN); }
  else if (idx < 896) { idx -= 640; W = p.w_out; K = 1024; N = 1024; Wt = (bf16_t*)(p.ws + WS_WTOUT); }
  else if (idx < 2304) { idx -= 896; W = p.ffn_up; K = 1024; N = 5632; Wt = (bf16_t*)(p.ws + WS_WTUP); }
  else if (idx < 3008) { idx -= 2304; W = p.ffn_down; K = 2816; N = 1024; Wt = (bf16_t*)(p.ws + WS_WTDN); }
  else if (idx < 3024) { idx -= 3008; const int d = idx >> 3; idx &= 7; W = p.w_up + (size_t)d * 64 * 512; K = 64; N = 512; Wt = (bf16_t*)(p.ws + WS_WTLW) + (size_t)d * 512 * 64; }
  else if (idx < 3040) { idx -= 3024; const int d = idx >> 3; idx &= 7; W = p.a_up + (size_t)d * 64 * 512; K = 64; N = 512; Wt = (bf16_t*)(p.ws + WS_WTLA) + (size_t)d * 512 * 64; }
  else { idx -= 3040; W = p.g_up; K = 128; N = 512; Wt = (bf16_t*)(p.ws + WS_WTLG); }
  ntn = N >> 6;
  const int kt = idx / ntn, nt = idx - kt * ntn;
  transpose_tile(W, N, Wt, K, kt * 64, nt * 64, smem);
}

__device__ void rope_item(const Params& p, int idx) {
  const int e = idx * 256 + threadIdx.x;
  const int tok = e >> 5, s = e & 31;
  const float pos = (float)((s < 16) ? (tok >> 6) : (tok & 63));
  const int f = s & 15;
  const float inv = exp2f(-(float)f * (13.287712379549449f / 16.f));
  const float ang = pos * inv;
  const float rev = ang * 0.15915494309189535f;
  const float fr = rev - rintf(rev);
  float2* tab = (float2*)(p.ws + WS_ROPE);
  tab[e] = make_float2(__builtin_amdgcn_cosf(fr), __builtin_amdgcn_sinf(fr));
}

__device__ void phase0(const Params& p, char* smem) {
  const int total = 128 + 640 + 48 + 128;
  for (int item = blockIdx.x; item < total; item += gridDim.x) {
    if (item < 128) adaln_item(p, item >> 2, item & 3, smem);
    else if (item < 128 + 640) transpose_item(p, item - 128, smem);
    else if (item < 128 + 640 + 48) transpose_item(p, item - 128 - 640 + 3008, smem);
    else rope_item(p, item - 128 - 640 - 48);
    __syncthreads();
  }
}

__device__ void phase1(const Params& p) {
  const int lane = threadIdx.x & 63, wave = threadIdx.x >> 6;
  const float* mod = (const float*)(p.ws + WS_MODP);
  bf16_t* hb = (bf16_t*)(p.ws + WS_HBUF);
  for (int it = blockIdx.x; it < T_ALL / 4; it += gridDim.x) {
    const int t = it * 4 + wave;
    const float* x = xrow(p, t);
    const float* md = mod + modrow(t) * 2048;
    float4 v[4];
    float ss = 0.f;
#pragma unroll
    for (int i = 0; i < 4; ++i) {
      v[i] = *(const float4*)(x + (i * 64 + lane) * 4);
      ss += v[i].x * v[i].x + v[i].y * v[i].y + v[i].z * v[i].z + v[i].w * v[i].w;
    }
    ss = wave_sum(ss);
    const float rstd = rsqrtf(ss * (1.f / 1024.f) + 1e-6f);
#pragma unroll
    for (int i = 0; i < 4; ++i) {
      const int c = (i * 64 + lane) * 4;
      const float4 g = *(const float4*)(p.norm_mix_pre + c);
      float4 sh = *(const float4*)(md + c);
      float4 sc = *(const float4*)(md + 1024 + c);
#pragma unroll
      for (int kq = 1; kq < 4; ++kq) {
        const float4 s2 = *(const float4*)(md + kq * 9 * 2048 + c);
        const float4 c2 = *(const float4*)(md + kq * 9 * 2048 + 1024 + c);
        sh.x += s2.x; sh.y += s2.y; sh.z += s2.z; sh.w += s2.w;
        sc.x += c2.x; sc.y += c2.y; sc.z += c2.z; sc.w += c2.w;
      }
      const float o0 = v[i].x * rstd * g.x * (1.f + sc.x) + sh.x;
      const float o1 = v[i].y * rstd * g.y * (1.f + sc.y) + sh.y;
      const float o2 = v[i].z * rstd * g.z * (1.f + sc.z) + sh.z;
      const float o3 = v[i].w * rstd * g.w * (1.f + sc.w) + sh.w;
      *(uint2*)(hb + (size_t)t * DM + c) = make_uint2(pack2(o0, o1), pack2(o2, o3));
    }
  }
}

__device__ void phase2(const Params& p, char* smem) {
  const bf16_t* hb = (const bf16_t*)(p.ws + WS_HBUF);
  const bf16_t* wt = (const bf16_t*)(p.ws + WS_WTIN);
  bf16_t* pb = (bf16_t*)(p.ws + WS_PB);
  int mt, nt;
  bool have = xcd_tile(0, 20, mt, nt), pre = false;
  for (int it = 0; have; ++it) {
    int mt2 = 0, nt2 = 0;
    const bool have2 = xcd_tile(it + 1, 20, mt2, nt2);
    const bf16_t* nA_ = have2 ? (hb + (size_t)mt2 * 192 * DM) : nullptr;
    const bf16_t* nB_ = have2 ? (wt + (size_t)nt2 * 128 * DM) : nullptr;
    gemm_tile(hb + (size_t)mt * 192 * DM, DM, wt + (size_t)nt * 128 * DM, DM, DM, smem,
              [&](int ml, int nl, f32x4 a, f32x4 b2) {
                const int m = mt * 192 + ml, n = nt * 128 + nl;
                if (n >= 1536 && n < 1600) {
#pragma unroll
                  for (int e = 0; e < 4; ++e) { a[e] = 1.f - 2.f / (__expf(2.f * a[e]) + 1.f); b2[e] = 1.f - 2.f / (__expf(2.f * b2[e]) + 1.f); }
                } else if (n >= 1664 && n < 1792) {
#pragma unroll
                  for (int e = 0; e < 4; ++e) { a[e] = sigmoidf_(a[e]); b2[e] = sigmoidf_(b2[e]); }
                }
                *(u32x4*)(pb + (size_t)m * DIN + n) = (u32x4){pack2(a[0], a[1]), pack2(a[2], a[3]), pack2(b2[0], b2[1]), pack2(b2[2], b2[3])};
              }, pre, nA_, nB_);
    pre = have2; mt = mt2; nt = nt2; have = have2;
  }
}

__device__ __forceinline__ float half_sum(float v);
__device__ void prep_item(const Params& p, int item) {
  const int lane = threadIdx.x & 63, wave = threadIdx.x >> 6;
  const int hh = lane >> 5, l2 = (lane & 31) * 2;
  const bf16_t* pb = (const bf16_t*)(p.ws + WS_PB);
  bf16_t* qn = (bf16_t*)(p.ws + WS_QN);
  const float4* tab4 = (const float4*)(p.ws + WS_ROPE);
  const float2 qg = *(const float2*)(p.q_norm + l2), kg = *(const float2*)(p.k_norm + l2);
  const int slot2 = ((l2 >> 5) * 16 + (l2 & 15)) >> 1;
  const bool hi16 = (l2 & 16) != 0;
  unsigned vacc[4];
  const int t0 = item * 16 + wave * 4;
  const bool lat = t0 >= T_CTX;
  const int b = lat ? ((t0 - T_CTX) >> 10) : (t0 >> 8);
  const int pos0 = lat ? ((t0 - T_CTX) & 1023) : (t0 & 255);
#pragma unroll
  for (int i = 0; i < 4; ++i) {
    const int t = t0 + i, pos = pos0 + i;
    const bf16_t* row = pb + (size_t)t * DIN;
    unsigned qv[4], kx[4];
#pragma unroll
    for (int hp = 0; hp < 4; ++hp) {
      qv[hp] = *(const unsigned*)(row + 1792 + (hp * 2 + hh) * 64 + l2);
      kx[hp] = *(const unsigned*)(row + 512 + (hp * 2 + hh) * 64 + l2);
    }
    const unsigned kv = *(const unsigned*)(row + 2304 + hh * 64 + l2);
    const unsigned vv = *(const unsigned*)(row + 2432 + hh * 64 + l2);
    float4 cssn = make_float4(1.f, 0.f, 1.f, 0.f);
    if (lat) cssn = tab4[pos * 16 + slot2];
#pragma unroll
    for (int hp = 0; hp < 4; ++hp) {
      const float x0 = bflo(qv[hp]), x1 = bfhi(qv[hp]);
      const float ss = half_sum(x0 * x0 + x1 * x1);
      const float rs = rsqrtf(ss * (1.f / 64.f) + 1e-6f);
      float a0 = x0 * rs * qg.x, a1 = x1 * rs * qg.y;
      if (lat) {
        const float p0 = __int_as_float(__builtin_amdgcn_mov_dpp(__float_as_int(a0), 0x128, 0xF, 0xF, true));
        const float p1 = __int_as_float(__builtin_amdgcn_mov_dpp(__float_as_int(a1), 0x128, 0xF, 0xF, true));
        a0 = hi16 ? (p0 * cssn.y + a0 * cssn.x) : (a0 * cssn.x - p0 * cssn.y);
        a1 = hi16 ? (p1 * cssn.w + a1 * cssn.z) : (a1 * cssn.z - p1 * cssn.w);
      }
      const float sc = 0.125f * 1.4426950408889634f;
      *(unsigned*)(qn + (size_t)t * 512 + (hp * 2 + hh) * 64 + l2) = pack2(a0 * sc, a1 * sc);
    }
#pragma unroll
    for (int hp = 0; hp < 4; ++hp) {
      const float2 kw = *(const float2*)(p.k_k + (hp * 2 + hh) * 64 + l2);
      const float k0 = bflo(kx[hp]) * kw.x, k1 = bfhi(kx[hp]) * kw.y;
      const float s2 = half_sum(k0 * k0 + k1 * k1);
      if ((lane & 31) == 0) ((float*)(p.ws + WS_RN))[(size_t)t * 8 + hp * 2 + hh] = rsqrtf(s2 + 1e-12f);
    }
    {
      const int kvh = hh;
      const float x0 = bflo(kv), x1 = bfhi(kv);
      const float ss = half_sum(x0 * x0 + x1 * x1);
      const float rs = rsqrtf(ss * (1.f / 64.f) + 1e-6f);
      float a0 = x0 * rs * kg.x, a1 = x1 * rs * kg.y;
      vacc[i] = vv;
      if (!lat) {
        *(float2*)(p.out + OUT_CK + ((size_t)(b * 256 + pos) * 2 + kvh) * 64 + l2) = make_float2(a0, a1);
        *(float2*)(p.out + OUT_CV + ((size_t)(b * 256 + pos) * 2 + kvh) * 64 + l2) = make_float2(bflo(vv), bfhi(vv));
        *(unsigned*)((bf16_t*)(p.ws + WS_KNC) + ((size_t)(b * 2 + kvh) * 256 + pos) * 64 + l2) = pack2(a0, a1);
      } else {
        const float p0 = __int_as_float(__builtin_amdgcn_mov_dpp(__float_as_int(a0), 0x128, 0xF, 0xF, true));
        const float p1 = __int_as_float(__builtin_amdgcn_mov_dpp(__float_as_int(a1), 0x128, 0xF, 0xF, true));
        a0 = hi16 ? (p0 * cssn.y + a0 * cssn.x) : (a0 * cssn.x - p0 * cssn.y);
        a1 = hi16 ? (p1 * cssn.w + a1 * cssn.z) : (a1 * cssn.z - p1 * cssn.w);
        *(unsigned*)((bf16_t*)(p.ws + WS_KNL) + ((size_t)(b * 2 + kvh) * 1280 + pos) * 64 + l2) = pack2(a0, a1);
      }
    }
  }
  {
    const int kvh = hh;
    const uint2 lo = make_uint2((vacc[0] & 0xffffu) | (vacc[1] << 16), (vacc[2] & 0xffffu) | (vacc[3] << 16));
    const uint2 hi = make_uint2((vacc[0] >> 16) | (vacc[1] & 0xffff0000u), (vacc[2] >> 16) | (vacc[3] & 0xffff0000u));
    bf16_t* vb = lat ? ((bf16_t*)(p.ws + WS_VTL) + ((size_t)(b * 2 + kvh) * 64 + l2) * 1280 + pos0)
                     : ((bf16_t*)(p.ws + WS_VTC) + ((size_t)(b * 2 + kvh) * 64 + l2) * 256 + pos0);
    const int ld = lat ? 1280 : 256;
    *(uint2*)vb = lo;
    *(uint2*)(vb + ld) = hi;
  }
}

__device__ void cache_item(const Params& p, int item) {
  for (int i = 0; i < 4; ++i) {
    const int e = item * 1024 + i * 256 + threadIdx.x;
    const int d = e & 63, kvh = (e >> 6) & 1, pp = (e >> 7) & 255, b = e >> 15;
    ((bf16_t*)(p.ws + WS_KNL))[((size_t)(b * 2 + kvh) * 1280 + 1024 + pp) * 64 + d] = (bf16_t)f2bf(p.cache_k[e]);
  }
  {
    const int q = item * 256 + threadIdx.x;
    const int d = q & 63, kvh = (q >> 6) & 1, pg = (q >> 7) & 63, b = q >> 13;
    unsigned v[4];
#pragma unroll
    for (int j = 0; j < 4; ++j) v[j] = f2bf(p.cache_v[(((size_t)b * 256 + pg * 4 + j) * 2 + kvh) * 64 + d]);
    *(uint2*)((bf16_t*)(p.ws + WS_VTL) + ((size_t)(b * 2 + kvh) * 64 + d) * 1280 + 1024 + pg * 4) = make_uint2(v[0] | (v[1] << 16), v[2] | (v[3] << 16));
  }
}

__device__ void lora_tile(const Params& p, int tile, char* smem) {
  const bf16_t* pb = (const bf16_t*)(p.ws + WS_PB);
  bf16_t* lb = (bf16_t*)(p.ws + WS_LB);
  const int mt = tile / 20, nt = tile - mt * 20;
  const int grp = nt >> 2, n0 = (nt & 3) * 128;
  const bf16_t* A; const bf16_t* B; int K;
  if (grp < 2) { A = pb + 1536; K = 64; B = (const bf16_t*)(p.ws + WS_WTLW) + (size_t)(grp * 512 + n0) * 64; }
  else if (grp < 4) { A = pb + 1600; K = 64; B = (const bf16_t*)(p.ws + WS_WTLA) + (size_t)((grp - 2) * 512 + n0) * 64; }
  else { A = pb + 1664; K = 128; B = (const bf16_t*)(p.ws + WS_WTLG) + (size_t)n0 * 128; }
  gemm_tile(A + (size_t)mt * 192 * DIN, DIN, B, K, K, smem,
            [&](int ml, int nl, f32x4 a, f32x4 b2) {
              const int m = mt * 192 + ml, c = n0 + nl;
              if (grp < 2) {
#pragma unroll
                for (int e = 0; e < 4; ++e) {
                  a[e] = __expf(-0.6065306597126334f * sigmoidf_(p.w0[grp * 512 + c + e] + a[e]));
                  b2[e] = __expf(-0.6065306597126334f * sigmoidf_(p.w0[grp * 512 + c + 4 + e] + b2[e]));
                }
              } else if (grp < 4) {
#pragma unroll
                for (int e = 0; e < 4; ++e) {
                  a[e] = sigmoidf_(p.a0[(grp - 2) * 512 + c + e] + a[e]);
                  b2[e] = sigmoidf_(p.a0[(grp - 2) * 512 + c + 4 + e] + b2[e]);
                }
              }
              *(u32x4*)(lb + (size_t)m * DIN + grp * 512 + c) = (u32x4){pack2(a[0], a[1]), pack2(a[2], a[3]), pack2(b2[0], b2[1]), pack2(b2[2], b2[3])};
            });
}

__device__ void lora_item(const Params& p, int item, char* smem) {
  const bf16_t* pb = (const bf16_t*)(p.ws + WS_PB);
  bf16_t* lb = (bf16_t*)(p.ws + WS_LB);
  const int mt = item >> 2, sub = item & 3, pair = sub >> 1, j0 = (sub & 1) * 4;
  const int tid = threadIdx.x, lane = tid & 63, wave = tid >> 6;
  const int wm = wave >> 1, wn = wave & 1, l15 = lane & 15, q4 = lane >> 4;
  const int lrow = tid >> 3, lch = (tid & 7) ^ (lrow & 7);
  const bf16_t* ap = pb + (size_t)(mt * 128 + lrow) * DIN + (pair ? 1600 : 1536) + lch * 8;
  const bf16_t* bbase = (const bf16_t*)(p.ws + (pair ? WS_WTLA : WS_WTLW));
  const int prow = ((lrow >> 2) & 3) * 8 + (lrow >> 4) * 4 + (lrow & 3);
  unsigned aaddr[2], baddr[2];
  const unsigned sbase = lds_addr(smem);
#pragma unroll
  for (int ks = 0; ks < 2; ++ks) {
    const int ch = ks * 4 + q4;
    aaddr[ks] = sbase + (wm * 64 + l15) * 128 + ((ch ^ (l15 & 7)) << 4);
    baddr[ks] = sbase + (wn * 64 + l15) * 128 + ((ch ^ (l15 & 7)) << 4);
  }
#define LORA_STAGE_B(BUF, J) { const bf16_t* bp_ = bbase + (size_t)((J) * 128 + prow) * 64 + lch * 8; _Pragma("unroll") for (int i = 0; i < 4; ++i) \
    __builtin_amdgcn_global_load_lds((const unsigned*)(bp_ + (size_t)(32 * i) * 64), (LAS unsigned*)(smem + (BUF) * 32768 + 16384 + i * 4096 + wave * 1024), 16, 0, 0); }
  __syncthreads();
#pragma unroll
  for (int i = 0; i < 4; ++i) {
    __builtin_amdgcn_global_load_lds((const unsigned*)(ap + (size_t)(32 * i) * DIN), (LAS unsigned*)(smem + i * 4096 + wave * 1024), 16, 0, 0);
    __builtin_amdgcn_global_load_lds((const unsigned*)(ap + (size_t)(32 * i) * DIN), (LAS unsigned*)(smem + 32768 + i * 4096 + wave * 1024), 16, 0, 0);
  }
  LORA_STAGE_B(0, j0);
#define LORA_STEP(JJ, BUFOFF_) { \
    const int j = j0 + (JJ); \
    asm volatile("s_waitcnt vmcnt(0)" ::: "memory"); \
    __syncthreads(); \
    if ((JJ) + 1 < 4) LORA_STAGE_B(((JJ) + 1) & 1, j + 1); \
    f32x4 acc[4][4]; \
    _Pragma("unroll") for (int x = 0; x < 4; ++x) _Pragma("unroll") for (int y = 0; y < 4; ++y) acc[x][y] = (f32x4){0.f, 0.f, 0.f, 0.f}; \
    gemm_kstep128<BUFOFF_>(aaddr, baddr, acc); \
    const int grp = pair * 2 + (j >> 2), n0 = (j & 3) * 128; \
    _Pragma("unroll") for (int np = 0; np < 2; ++np) { \
      const int c = n0 + wn * 64 + np * 32 + q4 * 8; \
      const float* wq = (pair ? p.a0 : p.w0) + (grp & 1) * 512 + c; \
      const float4 w0 = *(const float4*)wq, w1 = *(const float4*)(wq + 4); \
      _Pragma("unroll") for (int mi = 0; mi < 4; ++mi) { \
        f32x4 a = acc[2 * np][mi], b2 = acc[2 * np + 1][mi]; \
        const int m = mt * 128 + wm * 64 + mi * 16 + l15; \
        a[0] = sigmoidf_(w0.x + a[0]); a[1] = sigmoidf_(w0.y + a[1]); a[2] = sigmoidf_(w0.z + a[2]); a[3] = sigmoidf_(w0.w + a[3]); \
        b2[0] = sigmoidf_(w1.x + b2[0]); b2[1] = sigmoidf_(w1.y + b2[1]); b2[2] = sigmoidf_(w1.z + b2[2]); b2[3] = sigmoidf_(w1.w + b2[3]); \
        if (pair == 0) { \
          _Pragma("unroll") for (int e = 0; e < 4; ++e) { a[e] = __expf(-0.6065306597126334f * a[e]); b2[e] = __expf(-0.6065306597126334f * b2[e]); } \
        } \
        *(u32x4*)(lb + (size_t)m * DIN + grp * 512 + c) = (u32x4){pack2(a[0], a[1]), pack2(a[2], a[3]), pack2(b2[0], b2[1]), pack2(b2[2], b2[3])}; \
      } \
      __builtin_amdgcn_sched_barrier(0); \
    } }
  for (int jp = 0; jp < 4; jp += 2) {
    LORA_STEP(jp, 0);
    LORA_STEP(jp + 1, 32768);
  }
}

__device__ void phase3(const Params& p, char* smem, int mask = 3) {
  const int n1 = 384, n2 = 256, np = T_ALL / 16, nc = 256;
  for (int item = blockIdx.x; item < n1 + n2 + np + nc; item += gridDim.x) {
    if (item < n1) { if (mask & 1) lora_item(p, item, smem); }
    else if (item < n1 + n2) { if (mask & 1) { const int t2 = item - n1; lora_tile(p, (t2 >> 2) * 20 + 16 + (t2 & 3), smem); } }
    else if (item < n1 + n2 + np) { if (mask & 2) prep_item(p, item - n1 - n2); }
    else { if (mask & 2) cache_item(p, item - n1 - n2 - np); }
  }
}

struct ScanOps { f32x4 kk[2], w[2], b[2], kd[2], r[2]; float v; };
__device__ __forceinline__ void scan_load_ops(ScanOps& o, const float* tk, int kq, int row) {
  const float* q = tk + kq * 8;
  o.kk[0] = *(const f32x4*)(q);       o.kk[1] = *(const f32x4*)(q + 4);
  o.w[0]  = *(const f32x4*)(q + 64);  o.w[1]  = *(const f32x4*)(q + 68);
  o.b[0]  = *(const f32x4*)(q + 128); o.b[1]  = *(const f32x4*)(q + 132);
  o.kd[0] = *(const f32x4*)(q + 192); o.kd[1] = *(const f32x4*)(q + 196);
  o.r[0]  = *(const f32x4*)(q + 256); o.r[1]  = *(const f32x4*)(q + 260);
  o.v = tk[320 + row];
}
__device__ __forceinline__ float oct_sum(float x) {
  x += __int_as_float(__builtin_amdgcn_mov_dpp(__float_as_int(x), 0xB1, 0xF, 0xF, true));
  x += __int_as_float(__builtin_amdgcn_mov_dpp(__float_as_int(x), 0x4E, 0xF, 0xF, true));
  x += __int_as_float(__builtin_amdgcn_mov_dpp(__float_as_int(x), 0x141, 0xF, 0xF, true));
  return x;
}
__device__ __forceinline__ float scan_step(float (&S)[8], const ScanOps& o) {
  float s0 = S[0] * o.kk[0][0], s1 = S[1] * o.kk[0][1], s2 = S[2] * o.kk[0][2], s3 = S[3] * o.kk[0][3];
  s0 += S[4] * o.kk[1][0]; s1 += S[5] * o.kk[1][1]; s2 += S[6] * o.kk[1][2]; s3 += S[7] * o.kk[1][3];
  const float sa = -oct_sum((s0 + s1) + (s2 + s3));
  float y0 = 0.f, y1 = 0.f, y2 = 0.f, y3 = 0.f;
#pragma unroll
  for (int q = 0; q < 2; ++q) {
    S[q * 4 + 0] = S[q * 4 + 0] * o.w[q][0] + (sa * o.b[q][0] + o.v * o.kd[q][0]);
    S[q * 4 + 1] = S[q * 4 + 1] * o.w[q][1] + (sa * o.b[q][1] + o.v * o.kd[q][1]);
    S[q * 4 + 2] = S[q * 4 + 2] * o.w[q][2] + (sa * o.b[q][2] + o.v * o.kd[q][2]);
    S[q * 4 + 3] = S[q * 4 + 3] * o.w[q][3] + (sa * o.b[q][3] + o.v * o.kd[q][3]);
    y0 += S[q * 4 + 0] * o.r[q][0]; y1 += S[q * 4 + 1] * o.r[q][1];
    y2 += S[q * 4 + 2] * o.r[q][2]; y3 += S[q * 4 + 3] * o.r[q][3];
  }
  return oct_sum((y0 + y1) + (y2 + y3));
}

__device__ void scan_chain(const Params& p, int item, char* smem) {
  const int tid = threadIdx.x, lane = tid & 63, wave = tid >> 6;
  const int half = item & 1, chain = item >> 1;
  int b, h, d, L, tb; bool lat;
  if (chain < 128) { lat = true; b = chain >> 4; h = (chain >> 1) & 7; d = chain & 1; L = 1024; tb = T_CTX + b * 1024; }
  else { const int c2 = chain - 128; lat = false; b = c2 >> 4; h = (c2 >> 1) & 7; d = c2 & 1; L = 256; tb = b * 256; }
  const int row = half * 32 + wave * 8 + (lane >> 3), kq = lane & 7;
  float S[8];
  if (lat) {
    const float* sp = p.state_rwkv + ((((size_t)b * 2 + d) * 8 + h) * 64 + row) * 64 + kq * 8;
    const f32x4 v0 = *(const f32x4*)sp, v1 = *(const f32x4*)(sp + 4);
    S[0] = v0[0]; S[1] = v0[1]; S[2] = v0[2]; S[3] = v0[3]; S[4] = v1[0]; S[5] = v1[1]; S[6] = v1[2]; S[7] = v1[3];
  } else {
#pragma unroll
    for (int j = 0; j < 8; ++j) S[j] = 0.f;
  }
  float* buf = (float*)smem;
  const bf16_t* pb = (const bf16_t*)(p.ws + WS_PB);
  const bf16_t* lb = (const bf16_t*)(p.ws + WS_LB);
  float* yd = (float*)(p.ws + WS_YD) + (size_t)d * T_ALL * 512;
  const int c = h * 64 + lane;
  const float kkc = p.k_k[c], kac = p.k_a[c];
  unsigned rr[4], rk[4], rv[4], rw[4], ra[4];
  const int nch = L >> 4;
#define SCAN_LOAD(CH) { _Pragma("unroll") for (int i = 0; i < 4; ++i) { const int s_ = (CH) * 16 + wave + 4 * i; const int pos_ = d ? (L - 1 - s_) : s_; \
    const size_t t_ = (size_t)(tb + pos_) * DIN; rr[i] = pb[t_ + c]; rk[i] = pb[t_ + 512 + c]; rv[i] = pb[t_ + 1024 + c]; \
    rw[i] = lb[t_ + d * 512 + c]; ra[i] = lb[t_ + 1024 + d * 512 + c]; } }
#define SCAN_STAGE(BI) { _Pragma("unroll") for (int i = 0; i < 4; ++i) { const int slot_ = wave + 4 * i; \
    const float r_ = bf2f(rr[i]), k_ = bf2f(rk[i]), v_ = bf2f(rv[i]), w_ = bf2f(rw[i]), a_ = bf2f(ra[i]); \
    const float kkr_ = k_ * kkc; const float ss_ = wave_sum(kkr_ * kkr_); const float kk_ = kkr_ * rsqrtf(ss_ + 1e-12f); \
    const float kd_ = k_ * (1.f + (a_ - 1.f) * kac); float* o_ = buf + (((BI) * 16 + slot_) * 6) * 64 + lane; \
    o_[0] = kk_; o_[64] = w_; o_[128] = kk_ * a_; o_[192] = kd_; o_[256] = r_; o_[320] = v_; } }
  SCAN_LOAD(0);
  SCAN_STAGE(0);
  __syncthreads();
  if (nch > 1) SCAN_LOAD(1);
  float* ybase = yd + (size_t)tb * 512 + h * 64 + row;
  for (int ch = 0; ch < nch; ++ch) {
    const float* cb = buf + (ch & 1) * (16 * 6 * 64);
    ScanOps oa, ob;
    scan_load_ops(oa, cb, kq, row);
#pragma unroll
    for (int s = 0; s < 16; s += 2) {
      scan_load_ops(ob, cb + (s + 1) * 384, kq, row);
      const float ya = scan_step(S, oa);
      if (s + 2 < 16) scan_load_ops(oa, cb + (s + 2) * 384, kq, row);
      const float yb = scan_step(S, ob);
      const int sg = ch * 16 + s;
      const int pa = d ? (L - 1 - sg) : sg, pbb = d ? (L - 2 - sg) : (sg + 1);
      if (kq == 0) { ybase[(size_t)pa * 512] = ya; ybase[(size_t)pbb * 512] = yb; }
    }
    if (ch + 1 < nch) SCAN_STAGE((ch + 1) & 1);
    __syncthreads();
    if (ch + 2 < nch) SCAN_LOAD(ch + 2);
  }
  if (!lat) {
    float* so = p.out + OUT_ST + ((((size_t)b * 2 + d) * 8 + h) * 64 + row) * 64 + kq * 8;
    *(f32x4*)so = (f32x4){S[0], S[1], S[2], S[3]};
    *(f32x4*)(so + 4) = (f32x4){S[4], S[5], S[6], S[7]};
  }
  __syncthreads();
}

__device__ __forceinline__ float row16_sum(float x) {
  x += __int_as_float(__builtin_amdgcn_mov_dpp(__float_as_int(x), 0xB1, 0xF, 0xF, true));
  x += __int_as_float(__builtin_amdgcn_mov_dpp(__float_as_int(x), 0x4E, 0xF, 0xF, true));
  x += __int_as_float(__builtin_amdgcn_mov_dpp(__float_as_int(x), 0x141, 0xF, 0xF, true));
  x += __int_as_float(__builtin_amdgcn_mov_dpp(__float_as_int(x), 0x140, 0xF, 0xF, true));
  return x;
}
__device__ __forceinline__ bf16x8 mk8(unsigned a, unsigned b, unsigned c, unsigned d) {
  union { u32x4 u; bf16x8 v; } cv;
  cv.u = (u32x4){a, b, c, d};
  return cv.v;
}
#define DPP_F(X, CTRL) __int_as_float(__builtin_amdgcn_mov_dpp(__float_as_int(X), CTRL, 0xF, 0xF, true))
#define DPP_SHR1(X, N) __int_as_float(__builtin_amdgcn_update_dpp(0x3f800000, __float_as_int(X), 0x110 + (N), 0xF, 0xF, false))
__device__ void scan_chunked(const Params& p, int chain, char* smem) {
  const int tid = threadIdx.x, lane = tid & 63, l15 = lane & 15, q4 = lane >> 4;
  const int wave = __builtin_amdgcn_readfirstlane(tid >> 6);
  int b, h, d, L, tb; bool lat;
  if (chain < 128) { lat = true; b = chain >> 4; h = (chain >> 1) & 7; d = chain & 1; L = 1024; tb = T_CTX + b * 1024; }
  else { const int c2 = chain - 128; lat = false; b = c2 >> 4; h = (c2 >> 1) & 7; d = c2 & 1; L = 256; tb = b * 256; }
  __syncthreads();
  for (int i = tid; i < 512; i += 256) {
    ((bf16_t*)(smem + 14592))[i] = 0; ((bf16_t*)(smem + 16640))[i] = 0;
    ((bf16_t*)(smem + 17664 + 14592))[i] = 0; ((bf16_t*)(smem + 17664 + 16640))[i] = 0;
  }
  const int val = wave * 16 + l15;
  f32x4 st[4];
  if (lat) {
    const float* sp = p.state_rwkv + ((((size_t)b * 2 + d) * 8 + h) * 64 + val) * 64 + q4 * 4;
#pragma unroll
    for (int mb = 0; mb < 4; ++mb) st[mb] = *(const f32x4*)(sp + mb * 16);
  } else {
#pragma unroll
    for (int mb = 0; mb < 4; ++mb) st[mb] = (f32x4){0.f, 0.f, 0.f, 0.f};
  }
  const int te = tid & 15, cg = tid >> 4, c0 = cg * 4;
  const f32x4 kkc = *(const f32x4*)(p.k_k + h * 64 + c0), kac = *(const f32x4*)(p.k_a + h * 64 + c0);
  const bf16_t* pb = (const bf16_t*)(p.ws + WS_PB);
  const bf16_t* lb = (const bf16_t*)(p.ws + WS_LB);
  const float* rnp = (const float*)(p.ws + WS_RN);
  bf16_t* yd = (bf16_t*)(p.ws + WS_YD) + (size_t)d * T_ALL * 512;
  const int g_chunk = (cg >> 3) * 4 + (cg & 3), g_half = ((cg >> 2) & 1) * 8;
  const int g_off = te * 128 + ((g_chunk ^ (te & 7)) << 4) + g_half;
  const int m_slot = ((te >> 2) * 8 + (te & 3)) * 2;
  uint2 rr[4], rk[4], rv[4], rw[4], ra[4];
  float rn[4];
  const int nch = L >> 4;
#define CS_LOAD(SL, CH) { const int s_ = (CH) * 16 + te; const int pos_ = d ? (L - 1 - s_) : s_; const size_t t_ = (size_t)(tb + pos_) * DIN + h * 64 + c0; \
    rr[SL] = *(const uint2*)(pb + t_); rk[SL] = *(const uint2*)(pb + t_ + 512); rv[SL] = *(const uint2*)(pb + t_ + 1024); \
    rw[SL] = *(const uint2*)(lb + t_ + d * 512); ra[SL] = *(const uint2*)(lb + t_ + 1024 + d * 512); rn[SL] = rnp[(size_t)(tb + pos_) * 8 + h]; }
  CS_LOAD(0, 0); CS_LOAD(1, 1); CS_LOAD(2, 2); CS_LOAD(3, 3);
  __syncthreads();
  for (int ch4 = 0; ch4 < nch; ch4 += 4) {
#pragma unroll
  for (int sl = 0; sl < 4; ++sl) {
    const int ch = ch4 + sl;
    char* bufp = smem + (sl & 1) * 17664;
    char* G1 = bufp; char* HH = bufp + 4096; char* M3 = bufp + 8192; char* VT = bufp + 12288;
    float* GC = (float*)(bufp + 14336); char* MB = bufp + 14592; char* M2 = bufp + 15616; char* ML = bufp + 16640;
    {
      const float r4[4] = {bflo(rr[sl].x), bfhi(rr[sl].x), bflo(rr[sl].y), bfhi(rr[sl].y)};
      const float k4[4] = {bflo(rk[sl].x), bfhi(rk[sl].x), bflo(rk[sl].y), bfhi(rk[sl].y)};
      const float w4[4] = {bflo(rw[sl].x), bfhi(rw[sl].x), bflo(rw[sl].y), bfhi(rw[sl].y)};
      const float a4[4] = {bflo(ra[sl].x), bfhi(ra[sl].x), bflo(ra[sl].y), bfhi(ra[sl].y)};
      const uint2 vraw = rv[sl];
      const float rinv = rn[sl];
      float kap[4], rh[4], bb[4], kb[4], bh[4], k2[4], gcv[4];
#pragma unroll
      for (int e = 0; e < 4; ++e) {
        const float kk = k4[e] * kkc[e] * rinv;
        const float kd = k4[e] * (1.f + (a4[e] - 1.f) * kac[e]);
        const float be = kk * a4[e];
        float g = w4[e];
        g *= DPP_SHR1(g, 1); g *= DPP_SHR1(g, 2); g *= DPP_SHR1(g, 4); g *= DPP_SHR1(g, 8);
        const float gm1 = DPP_SHR1(g, 1);
        float tot = w4[e];
        tot *= DPP_F(tot, 0xB1); tot *= DPP_F(tot, 0x4E); tot *= DPP_F(tot, 0x141); tot *= DPP_F(tot, 0x140);
        const float ib = __builtin_amdgcn_rcpf(g);
        kap[e] = kk * gm1; rh[e] = r4[e] * g;
        bb[e] = be * ib; kb[e] = kd * ib;
        bh[e] = bb[e] * tot; k2[e] = kb[e] * tot; gcv[e] = tot;
      }
      *(uint2*)(G1 + g_off) = make_uint2(pack2(kap[0], kap[1]), pack2(kap[2], kap[3]));
      *(uint2*)(G1 + 2048 + g_off) = make_uint2(pack2(rh[0], rh[1]), pack2(rh[2], rh[3]));
      *(uint2*)(HH + g_off) = make_uint2(pack2(bb[0], bb[1]), pack2(bb[2], bb[3]));
      *(uint2*)(HH + 2048 + g_off) = make_uint2(pack2(kb[0], kb[1]), pack2(kb[2], kb[3]));
#pragma unroll
      for (int e = 0; e < 4; ++e) {
        const unsigned pm = pack2(-bh[e], k2[e]);
        *(bf16_t*)(M3 + (c0 + e) * 64 + m_slot) = (bf16_t)(pm & 0xffffu);
        *(bf16_t*)(M3 + (c0 + e) * 64 + m_slot + 8) = (bf16_t)(pm >> 16);
      }
      *(bf16_t*)(VT + (c0 + 0) * 32 + te * 2) = (bf16_t)(vraw.x & 0xffffu);
      *(bf16_t*)(VT + (c0 + 1) * 32 + te * 2) = (bf16_t)(vraw.x >> 16);
      *(bf16_t*)(VT + (c0 + 2) * 32 + te * 2) = (bf16_t)(vraw.y & 0xffffu);
      *(bf16_t*)(VT + (c0 + 3) * 32 + te * 2) = (bf16_t)(vraw.y >> 16);
      if (te == 15) *(f32x4*)(GC + c0) = (f32x4){gcv[0], gcv[1], gcv[2], gcv[3]};
    }
    __syncthreads();
    if (ch + 4 < nch) CS_LOAD(sl, ch + 4);
    {
      const int gi = wave >> 1, hi = wave & 1;
      f32x4 dacc = (f32x4){0.f, 0.f, 0.f, 0.f};
#pragma unroll
      for (int s2 = 0; s2 < 2; ++s2) {
        const int sw = ((s2 * 4 + q4) ^ (l15 & 7)) << 4;
        const bf16x8 af = *(const bf16x8*)(G1 + (gi * 16 + l15) * 128 + sw);
        const bf16x8 bv = *(const bf16x8*)(HH + (hi * 16 + l15) * 128 + sw);
        dacc = __builtin_amdgcn_mfma_f32_16x16x32_bf16(af, bv, dacc, 0, 0, 0);
      }
      const int sl2 = ((l15 >> 2) * 8 + (l15 & 3)) * 2;
      if (wave == 0) {
        float li[16];
#pragma unroll
        for (int t = 0; t < 16; ++t) {
          float v = (l15 == t) ? 1.f : 0.f;
#pragma unroll
          for (int i = 0; i < t; ++i) {
            const float a_ti = __int_as_float(__builtin_amdgcn_readlane(__float_as_int(dacc[t & 3]), (t >> 2) * 16 + i));
            v -= a_ti * li[i];
          }
          li[t] = v;
          __builtin_amdgcn_sched_barrier(0);
        }
#pragma unroll
        for (int j = 0; j < 4; ++j) {
          float lv = (q4 == 0) ? li[j] : (q4 == 1) ? li[4 + j] : (q4 == 2) ? li[8 + j] : li[12 + j];
          const unsigned pm = pack2(lv, 0.f);
          *(bf16_t*)(ML + (q4 * 4 + j) * 64 + sl2) = (bf16_t)(pm & 0xffffu);
        }
      } else {
#pragma unroll
        for (int j = 0; j < 4; ++j) {
          const int t = q4 * 4 + j, i = l15;
          float xv = dacc[j];
          if (wave == 1) xv = (i < t) ? xv : 0.f;
          else if (wave == 2) xv = (i <= t) ? -xv : 0.f;
          else xv = (i <= t) ? xv : 0.f;
          const unsigned pm = pack2(xv, 0.f);
          char* dst = (wave == 1) ? (MB + t * 64 + sl2 + 8) : (wave == 2) ? (M2 + t * 64 + sl2) : (M2 + t * 64 + sl2 + 8);
          *(bf16_t*)dst = (bf16_t)(pm & 0xffffu);
        }
      }
    }
    f32x4 xk = (f32x4){0.f, 0.f, 0.f, 0.f}, xr = xk;
#pragma unroll
    for (int s2 = 0; s2 < 2; ++s2) {
      const bf16x8 sb = mk8(pack2(st[2 * s2][0], st[2 * s2][1]), pack2(st[2 * s2][2], st[2 * s2][3]),
                            pack2(st[2 * s2 + 1][0], st[2 * s2 + 1][1]), pack2(st[2 * s2 + 1][2], st[2 * s2 + 1][3]));
      const int sw = ((s2 * 4 + q4) ^ (l15 & 7)) << 4;
      const bf16x8 ak = *(const bf16x8*)(G1 + l15 * 128 + sw);
      const bf16x8 ar = *(const bf16x8*)(G1 + 2048 + l15 * 128 + sw);
      xk = __builtin_amdgcn_mfma_f32_16x16x32_bf16(ak, sb, xk, 0, 0, 0);
      xr = __builtin_amdgcn_mfma_f32_16x16x32_bf16(ar, sb, xr, 0, 0, 0);
    }
    __syncthreads();
    const uint2 vt = *(const uint2*)(VT + val * 32 + q4 * 8);
    const f32x4 z = __builtin_amdgcn_mfma_f32_16x16x32_bf16(*(const bf16x8*)(MB + l15 * 64 + q4 * 16), mk8(0u, 0u, vt.x, vt.y), xk, 0, 0, 0);
    const f32x4 pt = __builtin_amdgcn_mfma_f32_16x16x32_bf16(*(const bf16x8*)(ML + l15 * 64 + q4 * 16),
                                                            mk8(pack2(z[0], z[1]), pack2(z[2], z[3]), 0u, 0u), (f32x4){0.f, 0.f, 0.f, 0.f}, 0, 0, 0);
    const bf16x8 b2 = mk8(pack2(pt[0], pt[1]), pack2(pt[2], pt[3]), vt.x, vt.y);
    const f32x4 yt = __builtin_amdgcn_mfma_f32_16x16x32_bf16(*(const bf16x8*)(M2 + l15 * 64 + q4 * 16), b2, xr, 0, 0, 0);
#pragma unroll
    for (int j = 0; j < 4; ++j) {
      const int s_ = ch * 16 + q4 * 4 + j;
      const int pos = d ? (L - 1 - s_) : s_;
      yd[(size_t)(tb + pos) * 512 + h * 64 + val] = (bf16_t)f2bf(yt[j]);
    }
#pragma unroll
    for (int mb = 0; mb < 4; ++mb) {
      const f32x4 g = *(const f32x4*)(GC + mb * 16 + q4 * 4);
      st[mb] = st[mb] * g;
      st[mb] = __builtin_amdgcn_mfma_f32_16x16x32_bf16(*(const bf16x8*)(M3 + (mb * 16 + l15) * 64 + q4 * 16), b2, st[mb], 0, 0, 0);
    }
  }
  }
  if (!lat) {
    float* so = p.out + OUT_ST + ((((size_t)b * 2 + d) * 8 + h) * 64 + val) * 64 + q4 * 4;
#pragma unroll
    for (int mb = 0; mb < 4; ++mb) *(f32x4*)(so + mb * 16) = st[mb];
  }
  __syncthreads();
}

__device__ void attn_item(const Params& p, int item, char* smem) {
  const int tid = threadIdx.x, lane = tid & 63, wave = tid >> 6;
  const int l15 = lane & 15, q4 = lane >> 4;
  int b, hq, qt, Lk, qtok0; const bf16_t* kn; const bf16_t* vt;
  if (item < 512) {
    b = item >> 6; hq = (item >> 3) & 7; qt = item & 7; Lk = 1280; qtok0 = T_CTX + b * 1024 + qt * 128;
    const int kvh = hq >> 2;
    kn = (const bf16_t*)(p.ws + WS_KNL) + (size_t)(b * 2 + kvh) * 1280 * 64;
    vt = (const bf16_t*)(p.ws + WS_VTL) + (size_t)(b * 2 + kvh) * 64 * 1280;
  } else {
    const int i2 = item - 512;
    b = i2 >> 4; hq = (i2 >> 1) & 7; qt = i2 & 1; Lk = 256; qtok0 = b * 256 + qt * 128;
    const int kvh = hq >> 2;
    kn = (const bf16_t*)(p.ws + WS_KNC) + (size_t)(b * 2 + kvh) * 256 * 64;
    vt = (const bf16_t*)(p.ws + WS_VTC) + (size_t)(b * 2 + kvh) * 64 * 256;
  }
  const bf16_t* qn = (const bf16_t*)(p.ws + WS_QN);
  bf16_t* am = (bf16_t*)(p.ws + WS_HBUF);
  char* Ks = smem; char* Vs = smem + 8192;
  bf16x8 qf[2][2];
#pragma unroll
  for (int qs = 0; qs < 2; ++qs)
#pragma unroll
    for (int ks = 0; ks < 2; ++ks)
      qf[qs][ks] = *(const bf16x8*)(qn + (size_t)(qtok0 + wave * 32 + qs * 16 + l15) * 512 + hq * 64 + ks * 32 + q4 * 8);
  f32x4 o[2][4];
#pragma unroll
  for (int qs = 0; qs < 2; ++qs)
#pragma unroll
    for (int db = 0; db < 4; ++db) o[qs][db] = (f32x4){0.f, 0.f, 0.f, 0.f};
  float mrun[2] = {-1e30f, -1e30f}, lsum[2] = {0.f, 0.f};
  u32x4 rk[2], rv[2];
  const int nkt = Lk >> 6;
#pragma unroll
  for (int i = 0; i < 2; ++i) {
    const int idx = tid + 256 * i, r = idx >> 3, ch = idx & 7;
    rk[i] = *(const u32x4*)(kn + (size_t)r * 64 + ch * 8);
    rv[i] = *(const u32x4*)(vt + (size_t)r * Lk + ch * 8);
  }
  for (int kt = 0; kt < nkt; ++kt) {
    __syncthreads();
#pragma unroll
    for (int i = 0; i < 2; ++i) {
      const int idx = tid + 256 * i, r = idx >> 3, ch = idx & 7;
      *(u32x4*)(Ks + r * 128 + ((ch ^ (r & 7)) << 4)) = rk[i];
      *(u32x4*)(Vs + r * 144 + ch * 16) = rv[i];
    }
    __syncthreads();
    if (kt + 1 < nkt) {
#pragma unroll
      for (int i = 0; i < 2; ++i) {
        const int idx = tid + 256 * i, r = idx >> 3, ch = idx & 7;
        rk[i] = *(const u32x4*)(kn + (size_t)((kt + 1) * 64 + r) * 64 + ch * 8);
        rv[i] = *(const u32x4*)(vt + (size_t)r * Lk + (kt + 1) * 64 + ch * 8);
      }
    }
    f32x4 s[2][4];
#pragma unroll
    for (int qs = 0; qs < 2; ++qs)
#pragma unroll
      for (int kb = 0; kb < 4; ++kb) s[qs][kb] = (f32x4){0.f, 0.f, 0.f, 0.f};
#pragma unroll
    for (int ks = 0; ks < 2; ++ks)
#pragma unroll
      for (int kb = 0; kb < 4; ++kb) {
        const int key = kb * 16 + l15, ch = ks * 4 + q4;
        const bf16x8 kf = *(const bf16x8*)(Ks + key * 128 + ((ch ^ (key & 7)) << 4));
#pragma unroll
        for (int qs = 0; qs < 2; ++qs) s[qs][kb] = __builtin_amdgcn_mfma_f32_16x16x32_bf16(kf, qf[qs][ks], s[qs][kb], 0, 0, 0);
      }
#pragma unroll
    for (int qs = 0; qs < 2; ++qs) {
      float mx = -1e30f;
#pragma unroll
      for (int kb = 0; kb < 4; ++kb)
#pragma unroll
        for (int j = 0; j < 4; ++j) mx = fmaxf(mx, s[qs][kb][j]);
      mx = fmaxf(mx, __shfl_xor(mx, 16));
      mx = fmaxf(mx, __shfl_xor(mx, 32));
      const float mn = fmaxf(mrun[qs], mx);
      const float alpha = __builtin_amdgcn_exp2f(mrun[qs] - mn);
      mrun[qs] = mn;
      float ps = 0.f;
#pragma unroll
      for (int kb = 0; kb < 4; ++kb)
#pragma unroll
        for (int j = 0; j < 4; ++j) { const float pv = __builtin_amdgcn_exp2f(s[qs][kb][j] - mn); s[qs][kb][j] = pv; ps += pv; }
      lsum[qs] = lsum[qs] * alpha + ps;
#pragma unroll
      for (int db = 0; db < 4; ++db) o[qs][db] *= alpha;
    }
#pragma unroll
    for (int s2 = 0; s2 < 2; ++s2) {
      bf16x8 pf[2];
#pragma unroll
      for (int qs = 0; qs < 2; ++qs) {
        union { uint4 u; bf16x8 v; } cv;
        cv.u = make_uint4(pack2(s[qs][2 * s2][0], s[qs][2 * s2][1]), pack2(s[qs][2 * s2][2], s[qs][2 * s2][3]),
                          pack2(s[qs][2 * s2 + 1][0], s[qs][2 * s2 + 1][1]), pack2(s[qs][2 * s2 + 1][2], s[qs][2 * s2 + 1][3]));
        pf[qs] = cv.v;
      }
#pragma unroll
      for (int db = 0; db < 4; ++db) {
        const char* vp = Vs + (db * 16 + l15) * 144 + (s2 * 32 + q4 * 4) * 2;
        const uint2 lo = *(const uint2*)vp;
        const uint2 hi = *(const uint2*)(vp + 32);
        union { uint4 u; bf16x8 v; } cv;
        cv.u = make_uint4(lo.x, lo.y, hi.x, hi.y);
#pragma unroll
        for (int qs = 0; qs < 2; ++qs) o[qs][db] = __builtin_amdgcn_mfma_f32_16x16x32_bf16(cv.v, pf[qs], o[qs][db], 0, 0, 0);
      }
    }
  }
#pragma unroll
  for (int qs = 0; qs < 2; ++qs) {
    float l = lsum[qs];
    l += __shfl_xor(l, 16);
    l += __shfl_xor(l, 32);
    const float inv = 1.f / l;
    const size_t tok = (size_t)(qtok0 + wave * 32 + qs * 16 + l15);
#pragma unroll
    for (int db = 0; db < 4; ++db) {
      const f32x4 v = o[qs][db] * inv;
      *(uint2*)(am + tok * DM + 512 + hq * 64 + db * 16 + q4 * 4) = make_uint2(pack2(v[0], v[1]), pack2(v[2], v[3]));
    }
  }
  __syncthreads();
}

__device__ void phase4(const Params& p, char* smem, unsigned* bar, volatile LAS unsigned* qslot, int rep) {
  unsigned* q0 = &bar[XB_QUEUE + 256 * rep];
  for (;;) {
    __syncthreads();
    if (threadIdx.x == 0) *qslot = xb_add(q0, 1u);
    __syncthreads();
    const unsigned item = *qslot;
    if (item >= 384u) break;
    scan_chunked(p, (int)item, smem);
  }
  for (;;) {
    __syncthreads();
    if (threadIdx.x == 0) *qslot = xb_add(q0 + 64, 1u);
    __syncthreads();
    const unsigned item = *qslot;
    if (item >= 768u) break;
    attn_item(p, (int)item, smem);
  }
  if (rep == 0) {
    for (;;) {
      __syncthreads();
      if (threadIdx.x == 0) *qslot = xb_add(q0 + 128, 1u);
      __syncthreads();
      const unsigned item = *qslot;
      if (item >= 360u) break;
      if (item < 64u) { __syncthreads(); adaln_item(p, 32 + (int)item, -1, smem); }
      else for (int j = 0; j < 8; ++j) { __syncthreads(); transpose_item(p, 640 + ((int)item - 64) * 8 + j, smem); }
    }
  }
}

__device__ __forceinline__ float half_sum(float v) {
  v += __int_as_float(__builtin_amdgcn_mov_dpp(__float_as_int(v), 0xB1, 0xF, 0xF, true));
  v += __int_as_float(__builtin_amdgcn_mov_dpp(__float_as_int(v), 0x4E, 0xF, 0xF, true));
  v += __int_as_float(__builtin_amdgcn_mov_dpp(__float_as_int(v), 0x141, 0xF, 0xF, true));
  v += __int_as_float(__builtin_amdgcn_mov_dpp(__float_as_int(v), 0x140, 0xF, 0xF, true));
  v += __shfl_xor(v, 16);
  return v;
}
__device__ void phase5(const Params& p) {
  const int lane = threadIdx.x & 63, wave = threadIdx.x >> 6;
  const int hh = lane >> 5, l2 = (lane & 31) * 2;
  const bf16_t* pb = (const bf16_t*)(p.ws + WS_PB);
  const bf16_t* lb = (const bf16_t*)(p.ws + WS_LB);
  const bf16_t* yd0 = (const bf16_t*)(p.ws + WS_YD);
  const bf16_t* yd1 = yd0 + (size_t)T_ALL * 512;
  bf16_t* am = (bf16_t*)(p.ws + WS_HBUF);
  for (int it = blockIdx.x; it < T_ALL / 4; it += gridDim.x) {
    const int t = it * 4 + wave;
    const bf16_t* prow = pb + (size_t)t * DIN;
    const bf16_t* lrow = lb + (size_t)t * DIN;
#pragma unroll 2
    for (int hp = 0; hp < 4; ++hp) {
      const int c = (hp * 2 + hh) * 64 + l2;
      const unsigned y0 = *(const unsigned*)(yd0 + (size_t)t * 512 + c), y1 = *(const unsigned*)(yd1 + (size_t)t * 512 + c);
      const unsigned ur = *(const unsigned*)(prow + c), uk = *(const unsigned*)(prow + 512 + c), uv = *(const unsigned*)(prow + 1024 + c);
      const unsigned ua0 = *(const unsigned*)(lrow + 1024 + c), ua1 = *(const unsigned*)(lrow + 1536 + c), ug = *(const unsigned*)(lrow + 2048 + c);
      const float2 gw = *(const float2*)(p.gn_w + c), gb = *(const float2*)(p.gn_b + c), ka = *(const float2*)(p.k_a + c), rk = *(const float2*)(p.r_k + c);
      const float ya = bflo(y0) + bflo(y1), yb = bfhi(y0) + bfhi(y1);
      const float mu = half_sum(ya + yb) * (1.f / 64.f);
      const float da = ya - mu, db = yb - mu;
      const float var = half_sum(da * da + db * db) * (1.f / 64.f);
      const float rs = rsqrtf(var + 64e-5f);
      const float kdsa = bflo(uk) * (2.f + (bflo(ua0) + bflo(ua1) - 2.f) * ka.x);
      const float kdsb = bfhi(uk) * (2.f + (bfhi(ua0) + bfhi(ua1) - 2.f) * ka.y);
      const float dot = half_sum(bflo(ur) * kdsa * rk.x + bfhi(ur) * kdsb * rk.y);
      const float oa = (da * rs * gw.x + gb.x + dot * bflo(uv)) * bflo(ug);
      const float ob = (db * rs * gw.y + gb.y + dot * bfhi(uv)) * bfhi(ug);
      *(unsigned*)(am + (size_t)t * DM + c) = pack2(oa, ob);
    }
  }
}

__device__ void phase6(const Params& p, char* smem) {
  const bf16_t* A = (const bf16_t*)(p.ws + WS_HBUF);
  const bf16_t* B = (const bf16_t*)(p.ws + WS_WTOUT);
  bf16_t* mix = (bf16_t*)(p.ws + WS_MIX);
  int mt, nt;
  bool have = xcd_tile(0, 8, mt, nt), pre = false;
  for (int it = 0; have; ++it) {
    int mt2 = 0, nt2 = 0;
    const bool have2 = xcd_tile(it + 1, 8, mt2, nt2);
    const bf16_t* nA_ = have2 ? (A + (size_t)mt2 * 192 * DM) : nullptr;
    const bf16_t* nB_ = have2 ? (B + (size_t)nt2 * 128 * DM) : nullptr;
    gemm_tile(A + (size_t)mt * 192 * DM, DM, B + (size_t)nt * 128 * DM, DM, DM, smem,
              [&](int ml, int nl, f32x4 a, f32x4 b2) { *(u32x4*)(mix + (size_t)(mt * 192 + ml) * DM + nt * 128 + nl) = (u32x4){pack2(a[0], a[1]), pack2(a[2], a[3]), pack2(b2[0], b2[1]), pack2(b2[2], b2[3])}; }, pre, nA_, nB_);
    pre = have2; mt = mt2; nt = nt2; have = have2;
  }
}
__device__ void phase8(const Params& p, char* smem) {
  const bf16_t* A = (const bf16_t*)(p.ws + WS_HBUF);
  const bf16_t* B = (const bf16_t*)(p.ws + WS_WTUP);
  bf16_t* u = (bf16_t*)(p.ws + WS_U);
  int mt, nt;
  bool have = xcd_tile(0, 44, mt, nt), pre = false;
  for (int it = 0; have; ++it) {
    int mt2 = 0, nt2 = 0;
    const bool have2 = xcd_tile(it + 1, 44, mt2, nt2);
    const bf16_t* nA_ = have2 ? (A + (size_t)mt2 * 192 * DM) : nullptr;
    const bf16_t* nB_ = have2 ? (B + (size_t)nt2 * 128 * DM) : nullptr;
    gemm_tile(A + (size_t)mt * 192 * DM, DM, B + (size_t)nt * 128 * DM, DM, DM, smem,
              [&](int ml, int nl, f32x4 a, f32x4 b2) {
                *(u32x4*)(u + (size_t)(mt * 192 + ml) * DFF2 + nt * 128 + nl) = (u32x4){pack2(a[0], a[1]), pack2(a[2], a[3]), pack2(b2[0], b2[1]), pack2(b2[2], b2[3])};
              }, pre, nA_, nB_);
    pre = have2; mt = mt2; nt = nt2; have = have2;
  }
}
__device__ void phase10(const Params& p, char* smem) {
  const bf16_t* A = (const bf16_t*)(p.ws + WS_ACT);
  const bf16_t* B = (const bf16_t*)(p.ws + WS_WTDN);
  bf16_t* f = (bf16_t*)(p.ws + WS_F);
  int mt, nt;
  bool have = xcd_tile(0, 8, mt, nt), pre = false;
  for (int it = 0; have; ++it) {
    int mt2 = 0, nt2 = 0;
    const bool have2 = xcd_tile(it + 1, 8, mt2, nt2);
    const bf16_t* nA_ = have2 ? (A + (size_t)mt2 * 192 * DFF) : nullptr;
    const bf16_t* nB_ = have2 ? (B + (size_t)nt2 * 128 * DFF) : nullptr;
    gemm_tile(A + (size_t)mt * 192 * DFF, DFF, B + (size_t)nt * 128 * DFF, DFF, DFF, smem,
              [&](int ml, int nl, f32x4 a, f32x4 b2) { *(u32x4*)(f + (size_t)(mt * 192 + ml) * DM + nt * 128 + nl) = (u32x4){pack2(a[0], a[1]), pack2(a[2], a[3]), pack2(b2[0], b2[1]), pack2(b2[2], b2[3])}; }, pre, nA_, nB_);
    pre = have2; mt = mt2; nt = nt2; have = have2;
  }
}

__device__ void phase7(const Params& p) {
  const int lane = threadIdx.x & 63, wave = threadIdx.x >> 6;
  const float* mod = (const float*)(p.ws + WS_MOD);
  const bf16_t* mix = (const bf16_t*)(p.ws + WS_MIX);
  bf16_t* hb = (bf16_t*)(p.ws + WS_HBUF);
  for (int it = blockIdx.x; it < T_ALL / 4; it += gridDim.x) {
    const int t = it * 4 + wave;
    const float* x = xrow(p, t);
    const float* md = mod + modrow(t) * 6144;
    float4 v[4];
    float ss = 0.f;
#pragma unroll
    for (int i = 0; i < 4; ++i) {
      { const uint2 u_ = *(const uint2*)(mix + (size_t)t * DM + (i * 64 + lane) * 4); v[i] = make_float4(bflo(u_.x), bfhi(u_.x), bflo(u_.y), bfhi(u_.y)); }
      ss += v[i].x * v[i].x + v[i].y * v[i].y + v[i].z * v[i].z + v[i].w * v[i].w;
    }
    ss = wave_sum(ss);
    const float rstd = rsqrtf(ss * (1.f / 1024.f) + 1e-6f);
    float ss2 = 0.f;
#pragma unroll
    for (int i = 0; i < 4; ++i) {
      const int c = (i * 64 + lane) * 4;
      const float4 xv = *(const float4*)(x + c);
      const float4 g = *(const float4*)(p.norm_mix_post + c);
      const float4 gt = *(const float4*)(md + 2048 + c);
      v[i].x = xv.x + gt.x * (v[i].x * rstd * g.x);
      v[i].y = xv.y + gt.y * (v[i].y * rstd * g.y);
      v[i].z = xv.z + gt.z * (v[i].z * rstd * g.z);
      v[i].w = xv.w + gt.w * (v[i].w * rstd * g.w);
      *(float4*)(p.out + (size_t)t * DM + c) = v[i];
      ss2 += v[i].x * v[i].x + v[i].y * v[i].y + v[i].z * v[i].z + v[i].w * v[i].w;
    }
    ss2 = wave_sum(ss2);
    const float rstd2 = rsqrtf(ss2 * (1.f / 1024.f) + 1e-6f);
#pragma unroll
    for (int i = 0; i < 4; ++i) {
      const int c = (i * 64 + lane) * 4;
      const float4 g = *(const float4*)(p.norm_ffn_pre + c);
      const float4 sh = *(const float4*)(md + 3072 + c);
      const float4 sc = *(const float4*)(md + 4096 + c);
      const float o0 = v[i].x * rstd2 * g.x * (1.f + sc.x) + sh.x;
      const float o1 = v[i].y * rstd2 * g.y * (1.f + sc.y) + sh.y;
      const float o2 = v[i].z * rstd2 * g.z * (1.f + sc.z) + sh.z;
      const float o3 = v[i].w * rstd2 * g.w * (1.f + sc.w) + sh.w;
      *(uint2*)(hb + (size_t)t * DM + c) = make_uint2(pack2(o0, o1), pack2(o2, o3));
    }
  }
}

__device__ void phase9(const Params& p) {
  const bf16_t* u = (const bf16_t*)(p.ws + WS_U);
  bf16_t* act = (bf16_t*)(p.ws + WS_ACT);
  const int cgi = threadIdx.x & 31, tsub = threadIdx.x >> 5;
  for (int it = blockIdx.x; it < 11 * 192; it += gridDim.x) {
    const int cb = it % 11, tt = it / 11;
    const int cc = (cb * 32 + cgi) * 8;
    const int t0 = tt * 64 + tsub * 8;
    const int L = t0 < T_CTX ? 256 : 1024;
    const int pos0 = t0 < T_CTX ? (t0 & 255) : ((t0 - T_CTX) & 1023);
    float wg[3][8], wv[3][8], bg[8], bv[8];
#pragma unroll
    for (int j = 0; j < 3; ++j) {
      const float4 a0 = *(const float4*)(p.conv_w + j * DFF2 + cc), a1 = *(const float4*)(p.conv_w + j * DFF2 + cc + 4);
      const float4 c0 = *(const float4*)(p.conv_w + j * DFF2 + DFF + cc), c1 = *(const float4*)(p.conv_w + j * DFF2 + DFF + cc + 4);
      wg[j][0] = a0.x; wg[j][1] = a0.y; wg[j][2] = a0.z; wg[j][3] = a0.w; wg[j][4] = a1.x; wg[j][5] = a1.y; wg[j][6] = a1.z; wg[j][7] = a1.w;
      wv[j][0] = c0.x; wv[j][1] = c0.y; wv[j][2] = c0.z; wv[j][3] = c0.w; wv[j][4] = c1.x; wv[j][5] = c1.y; wv[j][6] = c1.z; wv[j][7] = c1.w;
    }
    {
      const float4 a0 = *(const float4*)(p.conv_b + cc), a1 = *(const float4*)(p.conv_b + cc + 4);
      const float4 c0 = *(const float4*)(p.conv_b + DFF + cc), c1 = *(const float4*)(p.conv_b + DFF + cc + 4);
      bg[0] = a0.x; bg[1] = a0.y; bg[2] = a0.z; bg[3] = a0.w; bg[4] = a1.x; bg[5] = a1.y; bg[6] = a1.z; bg[7] = a1.w;
      bv[0] = c0.x; bv[1] = c0.y; bv[2] = c0.z; bv[3] = c0.w; bv[4] = c1.x; bv[5] = c1.y; bv[6] = c1.z; bv[7] = c1.w;
    }
    const bf16_t* ur = u + (size_t)t0 * DFF2 + cc;
    const u32x4 z = (u32x4){0u, 0u, 0u, 0u};
    u32x4 g0 = (pos0 > 0) ? *(const u32x4*)(ur - DFF2) : z;
    u32x4 v0 = (pos0 > 0) ? *(const u32x4*)(ur - DFF2 + DFF) : z;
    u32x4 g1 = *(const u32x4*)(ur);
    u32x4 v1 = *(const u32x4*)(ur + DFF);
#pragma unroll 4
    for (int i = 0; i < 8; ++i) {
      const bool hp = (pos0 + i) < L - 1;
      const u32x4 g2 = hp ? *(const u32x4*)(ur + (size_t)(i + 1) * DFF2) : z;
      const u32x4 v2 = hp ? *(const u32x4*)(ur + (size_t)(i + 1) * DFF2 + DFF) : z;
      unsigned o[4];
#pragma unroll
      for (int e2 = 0; e2 < 4; ++e2) {
        const float ga = bg[2 * e2] + wg[0][2 * e2] * bflo(g0[e2]) + wg[1][2 * e2] * bflo(g1[e2]) + wg[2][2 * e2] * bflo(g2[e2]);
        const float gb = bg[2 * e2 + 1] + wg[0][2 * e2 + 1] * bfhi(g0[e2]) + wg[1][2 * e2 + 1] * bfhi(g1[e2]) + wg[2][2 * e2 + 1] * bfhi(g2[e2]);
        const float va = bv[2 * e2] + wv[0][2 * e2] * bflo(v0[e2]) + wv[1][2 * e2] * bflo(v1[e2]) + wv[2][2 * e2] * bflo(v2[e2]);
        const float vb = bv[2 * e2 + 1] + wv[0][2 * e2 + 1] * bfhi(v0[e2]) + wv[1][2 * e2 + 1] * bfhi(v1[e2]) + wv[2][2 * e2 + 1] * bfhi(v2[e2]);
        o[e2] = pack2(ga * sigmoidf_(ga) * va, gb * sigmoidf_(gb) * vb);
      }
      *(u32x4*)(act + (size_t)(t0 + i) * DFF + cc) = (u32x4){o[0], o[1], o[2], o[3]};
      g0 = g1; g1 = g2; v0 = v1; v1 = v2;
    }
  }
}

__device__ void phase11(const Params& p) {
  const int lane = threadIdx.x & 63, wave = threadIdx.x >> 6;
  const float* mod = (const float*)(p.ws + WS_MOD);
  const bf16_t* f = (const bf16_t*)(p.ws + WS_F);
  for (int it = blockIdx.x; it < T_ALL / 4; it += gridDim.x) {
    const int t = it * 4 + wave;
    const float* md = mod + modrow(t) * 6144;
    float4 v[4];
    float ss = 0.f;
#pragma unroll
    for (int i = 0; i < 4; ++i) {
      { const uint2 u_ = *(const uint2*)(f + (size_t)t * DM + (i * 64 + lane) * 4); v[i] = make_float4(bflo(u_.x), bfhi(u_.x), bflo(u_.y), bfhi(u_.y)); }
      ss += v[i].x * v[i].x + v[i].y * v[i].y + v[i].z * v[i].z + v[i].w * v[i].w;
    }
    ss = wave_sum(ss);
    const float rstd = rsqrtf(ss * (1.f / 1024.f) + 1e-6f);
#pragma unroll
    for (int i = 0; i < 4; ++i) {
      const int c = (i * 64 + lane) * 4;
      float4 xv = *(const float4*)(p.out + (size_t)t * DM + c);
      const float4 g = *(const float4*)(p.norm_ffn_post + c);
      const float4 gt = *(const float4*)(md + 5120 + c);
      xv.x += gt.x * (v[i].x * rstd * g.x);
      xv.y += gt.y * (v[i].y * rstd * g.y);
      xv.z += gt.z * (v[i].z * rstd * g.z);
      xv.w += gt.w * (v[i].w * rstd * g.w);
      *(float4*)(p.out + (size_t)t * DM + c) = xv;
    }
  }
}

#define SMEM_BYTES 81920
__global__ void __launch_bounds__(256, 2) hybrid_fwd(Params p) {
  __shared__ __attribute__((aligned(16))) char smem[SMEM_BYTES];
  __syncthreads();
  unsigned* bar = (unsigned*)(p.ws + WS_BAR);
  XcdBarrier xb = xcd_barrier_post(bar);
  volatile LAS unsigned* qslot = (volatile LAS unsigned*)(smem + SMEM_BYTES - 16);

  const int zr = (int)xb_ld(&bar[8]);
#define RUNPH(N, CALL) { CALL; if (REPP == (N)) { xcd_barrier(xb); for (int r_ = 0; r_ < 1 + zr; ++r_) { CALL; } } }
  RUNPH(0, phase0(p, smem));
  xcd_barrier(xb);
  RUNPH(1, phase1(p));
  xcd_barrier(xb);
  RUNPH(2, phase2(p, smem));
  xcd_barrier(xb);
  phase3(p, smem);
  if (REPP == 31) { xcd_barrier(xb); phase3(p, smem, 1 + zr); }
  if (REPP == 32) { xcd_barrier(xb); phase3(p, smem, 2 + zr); }
  xcd_barrier(xb);
  phase4(p, smem, bar, qslot, 0);
  if (REPP == 4) { xcd_barrier(xb); phase4(p, smem, bar, qslot, 1); }
  xcd_barrier(xb);
  RUNPH(5, phase5(p));
  xcd_barrier(xb);
  RUNPH(6, phase6(p, smem));
  xcd_barrier(xb);
  RUNPH(7, phase7(p));
  xcd_barrier(xb);
  RUNPH(8, phase8(p, smem));
  xcd_barrier(xb);
  RUNPH(9, phase9(p));
  xcd_barrier(xb);
  RUNPH(10, phase10(p, smem));
  xcd_barrier(xb);
  phase11(p);
}

extern "C" void kernel_launch(void* const* d_in, const int* in_sizes, int n_in, void* d_out, int out_size,
                              void* d_ws, size_t ws_size, hipStream_t stream) {
  static int grid_blocks = 0;
  if (!grid_blocks) {
    int dev = 0, cus = 0, per_cu = 0;
    hipGetDevice(&dev);
    hipDeviceGetAttribute(&cus, hipDeviceAttributeMultiprocessorCount, dev);
    hipOccupancyMaxActiveBlocksPerMultiprocessor(&per_cu, hybrid_fwd, 256, 0);
    if (per_cu > 2) per_cu = 2;
    if (per_cu < 1) per_cu = 1;
    grid_blocks = cus * per_cu;
  }
  Params p{};
  const float** pp = (const float**)&p;
  for (int i = 0; i < 31; ++i) pp[i] = (const float*)d_in[i];
  p.out = (float*)d_out;
  p.ws = (char*)d_ws;
  hipMemsetAsync(d_ws, 0, 16384, stream);
  void* args[] = {&p};
  hipError_t e = hipLaunchCooperativeKernel((void*)hybrid_fwd, dim3(grid_blocks), dim3(256), args, 0, stream);
  if (e != hipSuccess) fprintf(stderr, "cooperative launch failed: %s (grid %d)\n", hipGetErrorString(e), grid_blocks);
}
```

```cpp
#include <hip/hip_runtime.h>
#include <stdint.h>
#include <cstdio>

typedef unsigned short bf16_t;
typedef short bf16x8 __attribute__((ext_vector_type(8)));
typedef float f32x4 __attribute__((ext_vector_type(4)));
typedef unsigned u32x4 __attribute__((ext_vector_type(4)));

#ifndef REPP
#define REPP -1
#endif
#define T_CTX 4096
#define T_ALL 12288
#define DM 1024
#define DIN 2560
#define DFF 2816
#define DFF2 5632

#define WS_BAR    0ul
#define WS_MOD    16384ul
#define WS_ROPE   (WS_MOD + 221184ul)
#define WS_WTIN   (WS_ROPE + 262144ul)
#define WS_WTOUT  (WS_WTIN + 5242880ul)
#define WS_WTUP   (WS_WTOUT + 2097152ul)
#define WS_WTDN   (WS_WTUP + 11534336ul)
#define WS_WTLW   (WS_WTDN + 5767168ul)
#define WS_WTLA   (WS_WTLW + 131072ul)
#define WS_WTLG   (WS_WTLA + 131072ul)
#define WS_HBUF   (WS_WTLG + 131072ul)
#define WS_AREA   (WS_HBUF + 25165824ul)
#define WS_PB     (WS_AREA)
#define WS_LB     (WS_PB + 62914560ul)
#define WS_QN     (WS_LB + 62914560ul)
#define WS_KNC    (WS_QN + 12582912ul)
#define WS_KNL    (WS_KNC + 1048576ul)
#define WS_VTC    (WS_KNL + 2621440ul)
#define WS_VTL    (WS_VTC + 1048576ul)
#define WS_YD     (WS_VTL + 2621440ul)
#define WS_RN     (WS_YD + 50331648ul)
#define WS_MODP   (WS_RN + 393216ul)
#define WS_MIX    (WS_AREA)
#define WS_U      (WS_AREA)
#define WS_ACT    (WS_AREA + 138412032ul)
#define WS_F      (WS_AREA)
#define WS_END    (WS_ACT + 69206016ul)
static_assert(WS_END <= 268435456ul, "workspace too large");
static_assert(WS_RN + 393216ul <= 268435456ul, "workspace too large");

#define OUT_CK 12582912ul
#define OUT_CV 13107200ul
#define OUT_ST 13631488ul

struct Params {
  const float *x_prompt, *x_sample, *cache_k, *cache_v, *state_rwkv, *c, *c_ctx, *w_mod, *b_mod,
      *norm_mix_pre, *norm_mix_post, *norm_ffn_pre, *norm_ffn_post, *w_in, *w0, *w_up, *a0, *a_up, *g_up,
      *k_k, *k_a, *r_k, *gn_w, *gn_b, *q_norm, *k_norm, *w_out, *ffn_up, *conv_w, *conv_b, *ffn_down;
  float* out;
  char* ws;
};

#define XB_TMO      128
#define XB_XCNT(j)  (256  + 64 * (j))
#define XB_XSUB(j)  (1280 + 64 * (j))
#define XB_XGEN(j)  (2304 + 64 * (j))
#define XB_TOP      3328
#define XB_TOPGEN   3392
#define XCD_BAR_WORDS 3456
#define XB_QUEUE    3520
#define XB_SPIN_CAP (1u << 22)
#define LAS __attribute__((address_space(3)))

__device__ __forceinline__ unsigned xb_ld(unsigned* p)              { return __hip_atomic_load(p, __ATOMIC_RELAXED, __HIP_MEMORY_SCOPE_AGENT); }
__device__ __forceinline__ unsigned xb_add(unsigned* p, unsigned v) { return __hip_atomic_fetch_add(p, v, __ATOMIC_RELAXED, __HIP_MEMORY_SCOPE_AGENT); }
__device__ __forceinline__ unsigned xb_xcc_id() { return (unsigned)__builtin_amdgcn_s_getreg((3 << 11) | 20) & 0xFu; }
#define XB_SPIN(cond, bar) do { unsigned _sp = 0; while (cond) { __builtin_amdgcn_s_sleep(1); \
    if ((++_sp & 255u) == 0u) { if (xb_ld(&(bar)[XB_TMO])) break; if (_sp > XB_SPIN_CAP) { atomicAdd(&(bar)[XB_TMO], 1u); break; } } } } while (0)

struct XcdBarrier { unsigned* bar; unsigned x; unsigned nloc, nx; };

__device__ __forceinline__ XcdBarrier xcd_barrier_post(unsigned* bar) {
  XcdBarrier b; b.bar = bar; b.x = xb_xcc_id(); b.nloc = 0u; b.nx = 0u;
  if (threadIdx.x == 0) (void)xb_add(&bar[XB_XCNT(b.x)], 1u);
  return b;
}
__device__ __forceinline__ void xcd_barrier_complete(unsigned* bar, unsigned x, unsigned& nloc, unsigned& nx) {
  const unsigned G = gridDim.x * gridDim.y * gridDim.z;
  unsigned sum, cnt, mine, sp = 0u;
  for (;;) {
    sum = 0u; cnt = 0u; mine = 0u;
#pragma unroll
    for (unsigned j = 0; j < 16; ++j) { const unsigned c = xb_ld(&bar[XB_XCNT(j)]); sum += c; cnt += (c > 0u) ? 1u : 0u; mine = (j == x) ? c : mine; }
    if (sum == G) break;
    __builtin_amdgcn_s_sleep(1);
    if ((++sp & 255u) == 0u) { if (xb_ld(&bar[XB_TMO])) break; if (sp > XB_SPIN_CAP) { atomicAdd(&bar[XB_TMO], 1u); break; } }
  }
  nloc = mine > 0u ? mine : 1u; nx = cnt > 0u ? cnt : 1u;
}
__device__ __forceinline__ void xcd_barrier(XcdBarrier& b) {
  asm volatile("s_waitcnt vmcnt(0)" ::: "memory");
  __syncthreads();
  if (threadIdx.x == 0) {
    unsigned* bar = b.bar;
    __builtin_amdgcn_s_waitcnt(0);
    unsigned nloc = b.nloc, nx = b.nx;
    if (nloc == 0u) { xcd_barrier_complete(bar, b.x, nloc, nx); b.nloc = nloc; b.nx = nx; }
    const unsigned old = xb_add(&bar[XB_XSUB(b.x)], 1u);
    const unsigned gen = old / nloc;
    if (old + 1u == (gen + 1u) * nloc) {
      __builtin_amdgcn_fence(__ATOMIC_RELEASE, "agent");
      asm volatile("s_waitcnt vmcnt(0)" ::: "memory");
      const unsigned og = xb_add(&bar[XB_TOP], 1u);
      const unsigned tg = og / nx;
      if (og + 1u == (tg + 1u) * nx) xb_add(&bar[XB_TOPGEN], 1u);
      else XB_SPIN(xb_ld(&bar[XB_TOPGEN]) == tg, bar);
      __builtin_amdgcn_fence(__ATOMIC_ACQUIRE, "agent");
      xb_add(&bar[XB_XGEN(b.x)], 1u);
      asm volatile("s_waitcnt vmcnt(0)" ::: "memory");
    } else {
      XB_SPIN(xb_ld(&bar[XB_XGEN(b.x)]) == gen, bar);
      __builtin_amdgcn_fence(__ATOMIC_ACQUIRE, "agent");
      asm volatile("s_waitcnt vmcnt(0)" ::: "memory");
    }
  }
  __syncthreads();
}

__device__ __forceinline__ unsigned f2bf(float f) { unsigned u = __float_as_uint(f); return (u + 0x7fffu + ((u >> 16) & 1u)) >> 16; }
typedef __bf16 bf16x2_t __attribute__((ext_vector_type(2)));
typedef float f32x2_t __attribute__((ext_vector_type(2)));
__device__ __forceinline__ unsigned pack2(float a, float b) {
  const f32x2_t v = {a, b};
  return __builtin_bit_cast(unsigned, __builtin_convertvector(v, bf16x2_t));
}
__device__ __forceinline__ float bf2f(unsigned b) { return __uint_as_float(b << 16); }
__device__ __forceinline__ float bflo(unsigned u) { return __uint_as_float(u << 16); }
__device__ __forceinline__ float bfhi(unsigned u) { return __uint_as_float(u & 0xffff0000u); }
__device__ __forceinline__ float wave_sum(float v) {
  v += __int_as_float(__builtin_amdgcn_mov_dpp(__float_as_int(v), 0xB1, 0xF, 0xF, true));
  v += __int_as_float(__builtin_amdgcn_mov_dpp(__float_as_int(v), 0x4E, 0xF, 0xF, true));
  v += __int_as_float(__builtin_amdgcn_mov_dpp(__float_as_int(v), 0x141, 0xF, 0xF, true));
  v += __int_as_float(__builtin_amdgcn_mov_dpp(__float_as_int(v), 0x140, 0xF, 0xF, true));
  const float a = __int_as_float(__builtin_amdgcn_readlane(__float_as_int(v), 0));
  const float b = __int_as_float(__builtin_amdgcn_readlane(__float_as_int(v), 16));
  const float c = __int_as_float(__builtin_amdgcn_readlane(__float_as_int(v), 32));
  const float d = __int_as_float(__builtin_amdgcn_readlane(__float_as_int(v), 48));
  return (a + b) + (c + d);
}
__device__ __forceinline__ float quad_sum(float x) {
  x += __int_as_float(__builtin_amdgcn_mov_dpp(__float_as_int(x), 0xB1, 0xF, 0xF, true));
  x += __int_as_float(__builtin_amdgcn_mov_dpp(__float_as_int(x), 0x4E, 0xF, 0xF, true));
  return x;
}
__device__ __forceinline__ float sigmoidf_(float x) { return 1.f / (1.f + __expf(-x)); }
__device__ __forceinline__ const float* xrow(const Params& p, int t) {
  return t < T_CTX ? p.x_prompt + (size_t)t * DM : p.x_sample + (size_t)(t - T_CTX) * DM;
}
__device__ __forceinline__ int modrow(int t) { return t < T_CTX ? 0 : 1 + ((t - T_CTX) >> 10); }

__device__ __forceinline__ unsigned lds_addr(const void* p) { return (unsigned)(size_t)(const LAS char*)p; }
template <int OFF>
__device__ __forceinline__ bf16x8 lds_read128(unsigned addr) {
  bf16x8 v;
  asm volatile("ds_read_b128 %0, %1 offset:%2" : "=v"(v) : "v"(addr), "n"(OFF));
  return v;
}
template <int BUFOFF>
__device__ __forceinline__ void gemm_kstep128(const unsigned (&aaddr)[2], const unsigned (&baddr)[2], f32x4 (&acc)[4][4]) {
  bf16x8 a0[4], b0[4], a1[4], b1[4];
  a0[0] = lds_read128<BUFOFF + 0>(aaddr[0]);    b0[0] = lds_read128<BUFOFF + 16384 + 0>(baddr[0]);
  a0[1] = lds_read128<BUFOFF + 2048>(aaddr[0]); b0[1] = lds_read128<BUFOFF + 16384 + 2048>(baddr[0]);
  a0[2] = lds_read128<BUFOFF + 4096>(aaddr[0]); b0[2] = lds_read128<BUFOFF + 16384 + 4096>(baddr[0]);
  a0[3] = lds_read128<BUFOFF + 6144>(aaddr[0]); b0[3] = lds_read128<BUFOFF + 16384 + 6144>(baddr[0]);
  a1[0] = lds_read128<BUFOFF + 0>(aaddr[1]);    b1[0] = lds_read128<BUFOFF + 16384 + 0>(baddr[1]);
  a1[1] = lds_read128<BUFOFF + 2048>(aaddr[1]); b1[1] = lds_read128<BUFOFF + 16384 + 2048>(baddr[1]);
  a1[2] = lds_read128<BUFOFF + 4096>(aaddr[1]); b1[2] = lds_read128<BUFOFF + 16384 + 4096>(baddr[1]);
  a1[3] = lds_read128<BUFOFF + 6144>(aaddr[1]); b1[3] = lds_read128<BUFOFF + 16384 + 6144>(baddr[1]);
  asm volatile("s_waitcnt lgkmcnt(8)" : "+v"(a0[0]), "+v"(a0[1]), "+v"(a0[2]), "+v"(a0[3]), "+v"(b0[0]), "+v"(b0[1]), "+v"(b0[2]), "+v"(b0[3]));
#pragma unroll
  for (int ni = 0; ni < 4; ++ni)
#pragma unroll
    for (int mi = 0; mi < 4; ++mi)
      acc[ni][mi] = __builtin_amdgcn_mfma_f32_16x16x32_bf16(b0[ni], a0[mi], acc[ni][mi], 0, 0, 0);
  __builtin_amdgcn_sched_barrier(0);
  asm volatile("s_waitcnt lgkmcnt(0)" : "+v"(a1[0]), "+v"(a1[1]), "+v"(a1[2]), "+v"(a1[3]), "+v"(b1[0]), "+v"(b1[1]), "+v"(b1[2]), "+v"(b1[3]));
#pragma unroll
  for (int ni = 0; ni < 4; ++ni)
#pragma unroll
    for (int mi = 0; mi < 4; ++mi)
      acc[ni][mi] = __builtin_amdgcn_mfma_f32_16x16x32_bf16(b1[ni], a1[mi], acc[ni][mi], 0, 0, 0);
  __builtin_amdgcn_sched_barrier(0);
}

template <int STOFF>
__device__ __forceinline__ void gemm_kstep(const unsigned (&aaddr)[2], const unsigned (&baddr)[2], f32x4 (&acc)[4][6]) {
#pragma unroll
  for (int ks = 0; ks < 2; ++ks) {
    bf16x8 a[3], b[4];
    a[0] = lds_read128<STOFF + 0>(aaddr[ks]);     b[0] = lds_read128<STOFF + 0>(baddr[ks]);
    b[1] = lds_read128<STOFF + 2048>(baddr[ks]);  b[2] = lds_read128<STOFF + 4096>(baddr[ks]);
    b[3] = lds_read128<STOFF + 6144>(baddr[ks]);
    a[1] = lds_read128<STOFF + 2048>(aaddr[ks]);  a[2] = lds_read128<STOFF + 4096>(aaddr[ks]);
    asm volatile("s_waitcnt lgkmcnt(2)" : "+v"(a[0]), "+v"(b[0]), "+v"(b[1]), "+v"(b[2]), "+v"(b[3]));
    __builtin_amdgcn_s_setprio(1);
#pragma unroll
    for (int ni = 0; ni < 4; ++ni) acc[ni][0] = __builtin_amdgcn_mfma_f32_16x16x32_bf16(b[ni], a[0], acc[ni][0], 0, 0, 0);
    __builtin_amdgcn_sched_barrier(0);
    a[0] = lds_read128<STOFF + 6144>(aaddr[ks]);
    asm volatile("s_waitcnt lgkmcnt(2)" : "+v"(a[1]));
#pragma unroll
    for (int ni = 0; ni < 4; ++ni) acc[ni][1] = __builtin_amdgcn_mfma_f32_16x16x32_bf16(b[ni], a[1], acc[ni][1], 0, 0, 0);
    __builtin_amdgcn_sched_barrier(0);
    a[1] = lds_read128<STOFF + 8192>(aaddr[ks]);
    asm volatile("s_waitcnt lgkmcnt(2)" : "+v"(a[2]));
#pragma unroll
    for (int ni = 0; ni < 4; ++ni) acc[ni][2] = __builtin_amdgcn_mfma_f32_16x16x32_bf16(b[ni], a[2], acc[ni][2], 0, 0, 0);
    __builtin_amdgcn_sched_barrier(0);
    a[2] = lds_read128<STOFF + 10240>(aaddr[ks]);
    asm volatile("s_waitcnt lgkmcnt(2)" : "+v"(a[0]));
#pragma unroll
    for (int ni = 0; ni < 4; ++ni) acc[ni][3] = __builtin_amdgcn_mfma_f32_16x16x32_bf16(b[ni], a[0], acc[ni][3], 0, 0, 0);
    __builtin_amdgcn_sched_barrier(0);
    asm volatile("s_waitcnt lgkmcnt(1)" : "+v"(a[1]));
#pragma unroll
    for (int ni = 0; ni < 4; ++ni) acc[ni][4] = __builtin_amdgcn_mfma_f32_16x16x32_bf16(b[ni], a[1], acc[ni][4], 0, 0, 0);
    __builtin_amdgcn_sched_barrier(0);
    asm volatile("s_waitcnt lgkmcnt(0)" : "+v"(a[2]));
#pragma unroll
    for (int ni = 0; ni < 4; ++ni) acc[ni][5] = __builtin_amdgcn_mfma_f32_16x16x32_bf16(b[ni], a[2], acc[ni][5], 0, 0, 0);
    __builtin_amdgcn_s_setprio(0);
    __builtin_amdgcn_sched_barrier(0);
  }
}

template <class Epi>
__device__ __forceinline__ void gemm_tile(const bf16_t* __restrict__ A, int lda, const bf16_t* __restrict__ B, int ldb, int K,
                                          char* smem, Epi&& epi, bool prestaged = false, const bf16_t* nA = nullptr, const bf16_t* nB = nullptr) {
  const int tid = threadIdx.x, lane = tid & 63, wave = tid >> 6;
  const int wm = wave >> 1, wn = wave & 1;
  const int l15 = lane & 15, q4 = lane >> 4;
  f32x4 acc[4][6];
#pragma unroll
  for (int i = 0; i < 4; ++i)
#pragma unroll
    for (int j = 0; j < 6; ++j) acc[i][j] = (f32x4){0.f, 0.f, 0.f, 0.f};
  const int lrow = tid >> 3, lch = (tid & 7) ^ (lrow & 7);
  const int prow = ((lrow >> 2) & 3) * 8 + (lrow >> 4) * 4 + (lrow & 3);
  const bf16_t* ap = A + (size_t)lrow * lda + lch * 8;
  const bf16_t* bp = B + (size_t)prow * ldb + lch * 8;
  const size_t lda32 = (size_t)32 * lda, ldb32 = (size_t)32 * ldb;
  const int nk = K >> 6;
  unsigned aaddr[2], baddr[2];
  const unsigned sbase = lds_addr(smem);
#pragma unroll
  for (int ks = 0; ks < 2; ++ks) {
    const int ch = ks * 4 + q4;
    aaddr[ks] = sbase + (wm * 96 + l15) * 128 + ((ch ^ (l15 & 7)) << 4);
    baddr[ks] = sbase + 24576 + (wn * 64 + l15) * 128 + ((ch ^ (l15 & 7)) << 4);
  }
#define GEMM_STAGE(BUF, K0) { _Pragma("unroll") for (int i = 0; i < 6; ++i) \
    __builtin_amdgcn_global_load_lds((const unsigned*)(ap + i * lda32 + (K0)), (LAS unsigned*)(smem + (BUF) * 40960 + i * 4096 + wave * 1024), 16, 0, 0); \
    _Pragma("unroll") for (int i = 0; i < 4; ++i) \
    __builtin_amdgcn_global_load_lds((const unsigned*)(bp + i * ldb32 + (K0)), (LAS unsigned*)(smem + (BUF) * 40960 + 24576 + i * 4096 + wave * 1024), 16, 0, 0); }
  if (!prestaged) {
    __syncthreads();
    GEMM_STAGE(0, 0);
  }
  for (int kt = 0; kt < nk; kt += 2) {
    asm volatile("s_waitcnt vmcnt(0)" ::: "memory");
    __syncthreads();
    if (kt + 1 < nk) GEMM_STAGE(1, (kt + 1) << 6);
    gemm_kstep<0>(aaddr, baddr, acc);
    if (kt + 1 < nk) {
      asm volatile("s_waitcnt vmcnt(0)" ::: "memory");
      __syncthreads();
      if (kt + 2 < nk) { GEMM_STAGE(0, (kt + 2) << 6); }
      else if (nA != nullptr) {
        const bf16_t* nap = nA + (size_t)lrow * lda + lch * 8;
        const bf16_t* nbp = nB + (size_t)prow * ldb + lch * 8;
#pragma unroll
        for (int i = 0; i < 6; ++i)
          __builtin_amdgcn_global_load_lds((const unsigned*)(nap + i * lda32), (LAS unsigned*)(smem + i * 4096 + wave * 1024), 16, 0, 0);
#pragma unroll
        for (int i = 0; i < 4; ++i)
          __builtin_amdgcn_global_load_lds((const unsigned*)(nbp + i * ldb32), (LAS unsigned*)(smem + 24576 + i * 4096 + wave * 1024), 16, 0, 0);
      }
      gemm_kstep<40960>(aaddr, baddr, acc);
    }
  }
#pragma unroll
  for (int np = 0; np < 2; ++np)
#pragma unroll
    for (int mi = 0; mi < 6; ++mi)
      epi(wm * 96 + mi * 16 + l15, wn * 64 + np * 32 + q4 * 8, acc[2 * np][mi], acc[2 * np + 1][mi]);
}

__device__ __forceinline__ bool xcd_tile(int it, int NT, int& mt, int& nt) {
  const int per = (int)(gridDim.x >> 3);
  const int x = blockIdx.x & 7, slot = blockIdx.x >> 3;
  if ((gridDim.x & 7) != 0) {
    const int tile = blockIdx.x + it * gridDim.x;
    if (tile >= 64 * NT) return false;
    mt = tile / NT; nt = tile - mt * NT; return true;
  }
  const int q = slot + it * per;
  if (q >= 8 * NT) return false;
  const int g = q / (4 * NT), r = q - g * 4 * NT;
  nt = r >> 2; mt = 8 * x + 4 * g + (r & 3);
  return true;
}

__device__ void adaln_item(const Params& p, int cb, int kq, char* smem) {
  const int tid = threadIdx.x, lane = tid & 63, wave = tid >> 6;
  float* s_act = (float*)smem;
  float* s_red = s_act + 9 * 1024;
  for (int i = tid; i < 9 * 1024; i += 256) {
    const int b = i >> 10, k = i & 1023;
    const float cv = (b == 0) ? p.c_ctx[k] : p.c[(b - 1) * 1024 + k];
    s_act[i] = cv / (1.f + __expf(-cv));
  }
  __syncthreads();
  const int c0 = cb * 64;
  float acc[9];
#pragma unroll
  for (int b = 0; b < 9; ++b) acc[b] = 0.f;
  const int kbase = (kq < 0) ? wave * 256 : kq * 256 + wave * 64;
  const int klen = (kq < 0) ? 256 : 64;
  const float* wp = p.w_mod + (size_t)kbase * 6144 + c0 + lane;
#pragma unroll 2
  for (int k = 0; k < klen; k += 16) {
    float wv[16];
#pragma unroll
    for (int j = 0; j < 16; ++j) wv[j] = wp[(size_t)(k + j) * 6144];
#pragma unroll
    for (int b = 0; b < 9; ++b) {
#pragma unroll
      for (int j4 = 0; j4 < 4; ++j4) {
        const float4 a = *(const float4*)&s_act[b * 1024 + kbase + k + j4 * 4];
        acc[b] += a.x * wv[j4 * 4] + a.y * wv[j4 * 4 + 1] + a.z * wv[j4 * 4 + 2] + a.w * wv[j4 * 4 + 3];
      }
    }
  }
#pragma unroll
  for (int b = 0; b < 9; ++b) s_red[(wave * 9 + b) * 64 + lane] = acc[b];
  __syncthreads();
  float* mod = (float*)(p.ws + WS_MOD);
  float* modp = (float*)(p.ws + WS_MODP);
  for (int i = tid; i < 9 * 64; i += 256) {
    const int b = i >> 6, l = i & 63;
    const float s = s_red[(0 * 9 + b) * 64 + l] + s_red[(1 * 9 + b) * 64 + l] + s_red[(2 * 9 + b) * 64 + l] + s_red[(3 * 9 + b) * 64 + l];
    if (kq < 0) mod[b * 6144 + c0 + l] = s + p.b_mod[c0 + l];
    else modp[(kq * 9 + b) * 2048 + c0 + l] = s + (kq == 0 ? p.b_mod[c0 + l] : 0.f);
  }
}

__device__ void transpose_tile(const float* __restrict__ W, int N, bf16_t* __restrict__ Wt, int ldt, int k0, int n0, char* smem) {
  const int tid = threadIdx.x;
  float* tile = (float*)smem;
#pragma unroll
  for (int r = 0; r < 4; ++r) {
    const int i = (tid >> 4) + 16 * r, j = (tid & 15) * 4;
    const float4 v = *(const float4*)(W + (size_t)(k0 + i) * N + n0 + j);
    tile[i * 65 + j + 0] = v.x; tile[i * 65 + j + 1] = v.y; tile[i * 65 + j + 2] = v.z; tile[i * 65 + j + 3] = v.w;
  }
  __syncthreads();
  const int n = tid >> 2, ks = (tid & 3) * 16;
  unsigned o[8];
#pragma unroll
  for (int e = 0; e < 8; ++e) o[e] = pack2(tile[(ks + 2 * e) * 65 + n], tile[(ks + 2 * e + 1) * 65 + n]);
  uint4* dst = (uint4*)(Wt + (size_t)(n0 + n) * ldt + k0 + ks);
  dst[0] = make_uint4(o[0], o[1], o[2], o[3]);
  dst[1] = make_uint4(o[4], o[5], o[6], o[7]);
}

__device__ void transpose_item(const Params& p, int idx, char* smem) {
  const float* W; int K, N; bf16_t* Wt; int ntn;
  if (idx < 640) { W = p.w_in; K = 1024; N = 2560; Wt = (bf16_t*)(p.ws + WS_WTIN); }
  else if (idx < 896) { idx -= 640; W = p.w_out; K = 1024; N = 1024; Wt = (bf16_t*)(p.ws + WS_WTOUT); }
  else if (idx < 2304) { idx -= 896; W = p.ffn_up; K = 1024; N = 5632; Wt = (bf16_t*)(p.ws + WS_WTUP); }
  else if (idx < 3008) { idx -= 2304; W = p.ffn_down; K = 2816; N = 1024; Wt = (bf16_t*)(p.ws + WS_WTDN); }
  else if (idx < 3024) { idx -= 3008; const int d = idx >> 3; idx &= 7; W = p.w_up + (size_t)d * 64 * 512; K = 64; N = 512; Wt = (bf16_t*)(p.ws + WS_WTLW) + (size_t)d * 512 * 64; }
  else if (idx < 3040) { idx -= 3024; const int d = idx >> 3; idx &= 7; W = p.a_up + (size_t)d * 64 * 512; K = 64; N = 512; Wt = (bf16_t*)(p.ws + WS_WTLA) + (size_t)d * 512 * 64; }
  else { idx -= 3040; W = p.g_up; K = 128; N = 512; Wt = (bf16_t*)(p.ws + WS_WTLG); }
  ntn = N >> 6;
  const int kt = idx / ntn, nt = idx - kt * ntn;
  transpose_tile(W, N, Wt, K, kt * 64, nt * 64, smem);
}

__device__ void rope_item(const Params& p, int idx) {
  const int e = idx * 256 + threadIdx.x;
  const int tok = e >> 5, s = e & 31;
  const float pos = (float)((s < 16) ? (tok >> 6) : (tok & 63));
  const int f = s & 15;
  const float inv = exp2f(-(float)f * (13.287712379549449f / 16.f));
  const float ang = pos * inv;
  const float rev = ang * 0.15915494309189535f;
  const float fr = rev - rintf(rev);
  float2* tab = (float2*)(p.ws + WS_ROPE);
  tab[e] = make_float2(__builtin_amdgcn_cosf(fr), __builtin_amdgcn_sinf(fr));
}

__device__ void phase0(const Params& p, char* smem) {
  const int total = 128 + 640 + 48 + 128;
  for (int item = blockIdx.x; item < total; item += gridDim.x) {
    if (item < 128) adaln_item(p, item >> 2, item & 3, smem);
    else if (item < 128 + 640) transpose_item(p, item - 128, smem);
    else if (item < 128 + 640 + 48) transpose_item(p, item - 128 - 640 + 3008, smem);
    else rope_item(p, item - 128 - 640 - 48);
    __syncthreads();
  }
}

__device__ void phase1(const Params& p) {
  const int lane = threadIdx.x & 63, wave = threadIdx.x >> 6;
  const float* mod = (const float*)(p.ws + WS_MODP);
  bf16_t* hb = (bf16_t*)(p.ws + WS_HBUF);
  for (int it = blockIdx.x; it < T_ALL / 4; it += gridDim.x) {
    const int t = it * 4 + wave;
    const float* x = xrow(p, t);
    const float* md = mod + modrow(t) * 2048;
    float4 v[4];
    float ss = 0.f;
#pragma unroll
    for (int i = 0; i < 4; ++i) {
      v[i] = *(const float4*)(x + (i * 64 + lane) * 4);
      ss += v[i].x * v[i].x + v[i].y * v[i].y + v[i].z * v[i].z + v[i].w * v[i].w;
    }
    ss = wave_sum(ss);
    const float rstd = rsqrtf(ss * (1.f / 1024.f) + 1e-6f);
#pragma unroll
    for (int i = 0; i < 4; ++i) {
      const int c = (i * 64 + lane) * 4;
      const float4 g = *(const float4*)(p.norm_mix_pre + c);
      float4 sh = *(const float4*)(md + c);
      float4 sc = *(const float4*)(md + 1024 + c);
#pragma unroll
      for (int kq = 1; kq < 4; ++kq) {
        const float4 s2 = *(const float4*)(md + kq * 9 * 2048 + c);
        const float4 c2 = *(const float4*)(md + kq * 9 * 2048 + 1024 + c);
        sh.x += s2.x; sh.y += s2.y; sh.z += s2.z; sh.w += s2.w;
        sc.x += c2.x; sc.y += c2.y; sc.z += c2.z; sc.w += c2.w;
      }
      const float o0 = v[i].x * rstd * g.x * (1.f + sc.x) + sh.x;
      const float o1 = v[i].y * rstd * g.y * (1.f + sc.y) + sh.y;
      const float o2 = v[i].z * rstd * g.z * (1.f + sc.z) + sh.z;
      const float o3 = v[i].w * rstd * g.w * (1.f + sc.w) + sh.w;
      *(uint2*)(hb + (size_t)t * DM + c) = make_uint2(pack2(o0, o1), pack2(o2, o3));
    }
  }
}

__device__ void phase2(const Params& p, char* smem) {
  const bf16_t* hb = (const bf16_t*)(p.ws + WS_HBUF);
  const bf16_t* wt = (const bf16_t*)(p.ws + WS_WTIN);
  bf16_t* pb = (bf16_t*)(p.ws + WS_PB);
  int mt, nt;
  bool have = xcd_tile(0, 20, mt, nt), pre = false;
  for (int it = 0; have; ++it) {
    int mt2 = 0, nt2 = 0;
    const bool have2 = xcd_tile(it + 1, 20, mt2, nt2);
    const bf16_t* nA_ = have2 ? (hb + (size_t)mt2 * 192 * DM) : nullptr;
    const bf16_t* nB_ = have2 ? (wt + (size_t)nt2 * 128 * DM) : nullptr;
    gemm_tile(hb + (size_t)mt * 192 * DM, DM, wt + (size_t)nt * 128 * DM, DM, DM, smem,
              [&](int ml, int nl, f32x4 a, f32x4 b2) {
                const int m = mt * 192 + ml, n = nt * 128 + nl;
                if (n >= 1536 && n < 1600) {
#pragma unroll
                  for (int e = 0; e < 4; ++e) { a[e] = 1.f - 2.f / (__expf(2.f * a[e]) + 1.f); b2[e] = 1.f - 2.f / (__expf(2.f * b2[e]) + 1.f); }
                } else if (n >= 1664 && n < 1792) {
#pragma unroll
                  for (int e = 0; e < 4; ++e) { a[e] = sigmoidf_(a[e]); b2[e] = sigmoidf_(b2[e]); }
                }
                *(u32x4*)(pb + (size_t)m * DIN + n) = (u32x4){pack2(a[0], a[1]), pack2(a[2], a[3]), pack2(b2[0], b2[1]), pack2(b2[2], b2[3])};
              }, pre, nA_, nB_);
    pre = have2; mt = mt2; nt = nt2; have = have2;
  }
}

__device__ __forceinline__ float half_sum(float v);
__device__ void prep_item(const Params& p, int item) {
  const int lane = threadIdx.x & 63, wave = threadIdx.x >> 6;
  const int hh = lane >> 5, l2 = (lane & 31) * 2;
  const bf16_t* pb = (const bf16_t*)(p.ws + WS_PB);
  bf16_t* qn = (bf16_t*)(p.ws + WS_QN);
  const float4* tab4 = (const float4*)(p.ws + WS_ROPE);
  const float2 qg = *(const float2*)(p.q_norm + l2), kg = *(const float2*)(p.k_norm + l2);
  const int slot2 = ((l2 >> 5) * 16 + (l2 & 15)) >> 1;
  const bool hi16 = (l2 & 16) != 0;
  unsigned vacc[4];
  const int t0 = item * 16 + wave * 4;
  const bool lat = t0 >= T_CTX;
  const int b = lat ? ((t0 - T_CTX) >> 10) : (t0 >> 8);
  const int pos0 = lat ? ((t0 - T_CTX) & 1023) : (t0 & 255);
#pragma unroll
  for (int i = 0; i < 4; ++i) {
    const int t = t0 + i, pos = pos0 + i;
    const bf16_t* row = pb + (size_t)t * DIN;
    unsigned qv[4], kx[4];
#pragma unroll
    for (int hp = 0; hp < 4; ++hp) {
      qv[hp] = *(const unsigned*)(row + 1792 + (hp * 2 + hh) * 64 + l2);
      kx[hp] = *(const unsigned*)(row + 512 + (hp * 2 + hh) * 64 + l2);
    }
    const unsigned kv = *(const unsigned*)(row + 2304 + hh * 64 + l2);
    const unsigned vv = *(const unsigned*)(row + 2432 + hh * 64 + l2);
    float4 cssn = make_float4(1.f, 0.f, 1.f, 0.f);
    if (lat) cssn = tab4[pos * 16 + slot2];
#pragma unroll
    for (int hp = 0; hp < 4; ++hp) {
      const float x0 = bflo(qv[hp]), x1 = bfhi(qv[hp]);
      const float ss = half_sum(x0 * x0 + x1 * x1);
      const float rs = rsqrtf(ss * (1.f / 64.f) + 1e-6f);
      float a0 = x0 * rs * qg.x, a1 = x1 * rs * qg.y;
      if (lat) {
        const float p0 = __int_as_float(__builtin_amdgcn_mov_dpp(__float_as_int(a0), 0x128, 0xF, 0xF, true));
        const float p1 = __int_as_float(__builtin_amdgcn_mov_dpp(__float_as_int(a1), 0x128, 0xF, 0xF, true));
        a0 = hi16 ? (p0 * cssn.y + a0 * cssn.x) : (a0 * cssn.x - p0 * cssn.y);
        a1 = hi16 ? (p1 * cssn.w + a1 * cssn.z) : (a1 * cssn.z - p1 * cssn.w);
      }
      const float sc = 0.125f * 1.4426950408889634f;
      *(unsigned*)(qn + (size_t)t * 512 + (hp * 2 + hh) * 64 + l2) = pack2(a0 * sc, a1 * sc);
    }
#pragma unroll
    for (int hp = 0; hp < 4; ++hp) {
      const float2 kw = *(const float2*)(p.k_k + (hp * 2 + hh) * 64 + l2);
      const float k0 = bflo(kx[hp]) * kw.x, k1 = bfhi(kx[hp]) * kw.y;
      const float s2 = half_sum(k0 * k0 + k1 * k1);
      if ((lane & 31) == 0) ((float*)(p.ws + WS_RN))[(size_t)t * 8 + hp * 2 + hh] = rsqrtf(s2 + 1e-12f);
    }
    {
      const int kvh = hh;
      const float x0 = bflo(kv), x1 = bfhi(kv);
      const float ss = half_sum(x0 * x0 + x1 * x1);
      const float rs = rsqrtf(ss * (1.f / 64.f) + 1e-6f);
      float a0 = x0 * rs * kg.x, a1 = x1 * rs * kg.y;
      vacc[i] = vv;
      if (!lat) {
        *(float2*)(p.out + OUT_CK + ((size_t)(b * 256 + pos) * 2 + kvh) * 64 + l2) = make_float2(a0, a1);
        *(float2*)(p.out + OUT_CV + ((size_t)(b * 256 + pos) * 2 + kvh) * 64 + l2) = make_float2(bflo(vv), bfhi(vv));
        *(unsigned*)((bf16_t*)(p.ws + WS_KNC) + ((size_t)(b * 2 + kvh) * 256 + pos) * 64 + l2) = pack2(a0, a1);
      } else {
        const float p0 = __int_as_float(__builtin_amdgcn_mov_dpp(__float_as_int(a0), 0x128, 0xF, 0xF, true));
        const float p1 = __int_as_float(__builtin_amdgcn_mov_dpp(__float_as_int(a1), 0x128, 0xF, 0xF, true));
        a0 = hi16 ? (p0 * cssn.y + a0 * cssn.x) : (a0 * cssn.x - p0 * cssn.y);
        a1 = hi16 ? (p1 * cssn.w + a1 * cssn.z) : (a1 * cssn.z - p1 * cssn.w);
        *(unsigned*)((bf16_t*)(p.ws + WS_KNL) + ((size_t)(b * 2 + kvh) * 1280 + pos) * 64 + l2) = pack2(a0, a1);
      }
    }
  }
  {
    const int kvh = hh;
    const uint2 lo = make_uint2((vacc[0] & 0xffffu) | (vacc[1] << 16), (vacc[2] & 0xffffu) | (vacc[3] << 16));
    const uint2 hi = make_uint2((vacc[0] >> 16) | (vacc[1] & 0xffff0000u), (vacc[2] >> 16) | (vacc[3] & 0xffff0000u));
    bf16_t* vb = lat ? ((bf16_t*)(p.ws + WS_VTL) + ((size_t)(b * 2 + kvh) * 64 + l2) * 1280 + pos0)
                     : ((bf16_t*)(p.ws + WS_VTC) + ((size_t)(b * 2 + kvh) * 64 + l2) * 256 + pos0);
    const int ld = lat ? 1280 : 256;
    *(uint2*)vb = lo;
    *(uint2*)(vb + ld) = hi;
  }
}

__device__ void cache_item(const Params& p, int item) {
  for (int i = 0; i < 4; ++i) {
    const int e = item * 1024 + i * 256 + threadIdx.x;
    const int d = e & 63, kvh = (e >> 6) & 1, pp = (e >> 7) & 255, b = e >> 15;
    ((bf16_t*)(p.ws + WS_KNL))[((size_t)(b * 2 + kvh) * 1280 + 1024 + pp) * 64 + d] = (bf16_t)f2bf(p.cache_k[e]);
  }
  {
    const int q = item * 256 + threadIdx.x;
    const int d = q & 63, kvh = (q >> 6) & 1, pg = (q >> 7) & 63, b = q >> 13;
    unsigned v[4];
#pragma unroll
    for (int j = 0; j < 4; ++j) v[j] = f2bf(p.cache_v[(((size_t)b * 256 + pg * 4 + j) * 2 + kvh) * 64 + d]);
    *(uint2*)((bf16_t*)(p.ws + WS_VTL) + ((size_t)(b * 2 + kvh) * 64 + d) * 1280 + 1024 + pg * 4) = make_uint2(v[0] | (v[1] << 16), v[2] | (v[3] << 16));
  }
}

__device__ void lora_tile(const Params& p, int tile, char* smem) {
  const bf16_t* pb = (const bf16_t*)(p.ws + WS_PB);
  bf16_t* lb = (bf16_t*)(p.ws + WS_LB);
  const int mt = tile / 20, nt = tile - mt * 20;
  const int grp = nt >> 2, n0 = (nt & 3) * 128;
  const bf16_t* A; const bf16_t* B; int K;
  if (grp < 2) { A = pb + 1536; K = 64; B = (const bf16_t*)(p.ws + WS_WTLW) + (size_t)(grp * 512 + n0) * 64; }
  else if (grp < 4) { A = pb + 1600; K = 64; B = (const bf16_t*)(p.ws + WS_WTLA) + (size_t)((grp - 2) * 512 + n0) * 64; }
  else { A = pb + 1664; K = 128; B = (const bf16_t*)(p.ws + WS_WTLG) + (size_t)n0 * 128; }
  gemm_tile(A + (size_t)mt * 192 * DIN, DIN, B, K, K, smem,
            [&](int ml, int nl, f32x4 a, f32x4 b2) {
              const int m = mt * 192 + ml, c = n0 + nl;
              if (grp < 2) {
#pragma unroll
                for (int e = 0; e < 4; ++e) {
                  a[e] = __expf(-0.6065306597126334f * sigmoidf_(p.w0[grp * 512 + c + e] + a[e]));
                  b2[e] = __expf(-0.6065306597126334f * sigmoidf_(p.w0[grp * 512 + c + 4 + e] + b2[e]));
                }
              } else if (grp < 4) {
#pragma unroll
                for (int e = 0; e < 4; ++e) {
                  a[e] = sigmoidf_(p.a0[(grp - 2) * 512 + c + e] + a[e]);
                  b2[e] = sigmoidf_(p.a0[(grp - 2) * 512 + c + 4 + e] + b2[e]);
                }
              }
              *(u32x4*)(lb + (size_t)m * DIN + grp * 512 + c) = (u32x4){pack2(a[0], a[1]), pack2(a[2], a[3]), pack2(b2[0], b2[1]), pack2(b2[2], b2[3])};
            });
}

__device__ void lora_item(const Params& p, int item, char* smem) {
  const bf16_t* pb = (const bf16_t*)(p.ws + WS_PB);
  bf16_t* lb = (bf16_t*)(p.ws + WS_LB);
  const int mt = item >> 2, sub = item & 3, pair = sub >> 1, j0 = (sub & 1) * 4;
  const int tid = threadIdx.x, lane = tid & 63, wave = tid >> 6;
  const int wm = wave >> 1, wn = wave & 1, l15 = lane & 15, q4 = lane >> 4;
  const int lrow = tid >> 3, lch = (tid & 7) ^ (lrow & 7);
  const bf16_t* ap = pb + (size_t)(mt * 128 + lrow) * DIN + (pair ? 1600 : 1536) + lch * 8;
  const bf16_t* bbase = (const bf16_t*)(p.ws + (pair ? WS_WTLA : WS_WTLW));
  const int prow = ((lrow >> 2) & 3) * 8 + (lrow >> 4) * 4 + (lrow & 3);
  unsigned aaddr[2], baddr[2];
  const unsigned sbase = lds_addr(smem);
#pragma unroll
  for (int ks = 0; ks < 2; ++ks) {
    const int ch = ks * 4 + q4;
    aaddr[ks] = sbase + (wm * 64 + l15) * 128 + ((ch ^ (l15 & 7)) << 4);
    baddr[ks] = sbase + (wn * 64 + l15) * 128 + ((ch ^ (l15 & 7)) << 4);
  }
#define LORA_STAGE_B(BUF, J) { const bf16_t* bp_ = bbase + (size_t)((J) * 128 + prow) * 64 + lch * 8; _Pragma("unroll") for (int i = 0; i < 4; ++i) \
    __builtin_amdgcn_global_load_lds((const unsigned*)(bp_ + (size_t)(32 * i) * 64), (LAS unsigned*)(smem + (BUF) * 32768 + 16384 + i * 4096 + wave * 1024), 16, 0, 0); }
  __syncthreads();
#pragma unroll
  for (int i = 0; i < 4; ++i) {
    __builtin_amdgcn_global_load_lds((const unsigned*)(ap + (size_t)(32 * i) * DIN), (LAS unsigned*)(smem + i * 4096 + wave * 1024), 16, 0, 0);
    __builtin_amdgcn_global_load_lds((const unsigned*)(ap + (size_t)(32 * i) * DIN), (LAS unsigned*)(smem + 32768 + i * 4096 + wave * 1024), 16, 0, 0);
  }
  LORA_STAGE_B(0, j0);
#define LORA_STEP(JJ, BUFOFF_) { \
    const int j = j0 + (JJ); \
    asm volatile("s_waitcnt vmcnt(0)" ::: "memory"); \
    __syncthreads(); \
    if ((JJ) + 1 < 4) LORA_STAGE_B(((JJ) + 1) & 1, j + 1); \
    f32x4 acc[4][4]; \
    _Pragma("unroll") for (int x = 0; x < 4; ++x) _Pragma("unroll") for (int y = 0; y < 4; ++y) acc[x][y] = (f32x4){0.f, 0.f, 0.f, 0.f}; \
    gemm_kstep128<BUFOFF_>(aaddr, baddr, acc); \
    const int grp = pair * 2 + (j >> 2), n0 = (j & 3) * 128; \
    _Pragma("unroll") for (int np = 0; np < 2; ++np) { \
      const int c = n0 + wn * 64 + np * 32 + q4 * 8; \
      const float* wq = (pair ? p.a0 : p.w0) + (grp & 1) * 512 + c; \
      const float4 w0 = *(const float4*)wq, w1 = *(const float4*)(wq + 4); \
      _Pragma("unroll") for (int mi = 0; mi < 4; ++mi) { \
        f32x4 a = acc[2 * np][mi], b2 = acc[2 * np + 1][mi]; \
        const int m = mt * 128 + wm * 64 + mi * 16 + l15; \
        a[0] = sigmoidf_(w0.x + a[0]); a[1] = sigmoidf_(w0.y + a[1]); a[2] = sigmoidf_(w0.z + a[2]); a[3] = sigmoidf_(w0.w + a[3]); \
        b2[0] = sigmoidf_(w1.x + b2[0]); b2[1] = sigmoidf_(w1.y + b2[1]); b2[2] = sigmoidf_(w1.z + b2[2]); b2[3] = sigmoidf_(w1.w + b2[3]); \
        if (pair == 0) { \
          _Pragma("unroll") for (int e = 0; e < 4; ++e) { a[e] = __expf(-0.6065306597126334f * a[e]); b2[e] = __expf(-0.6065306597126334f * b2[e]); } \
        } \
        *(u32x4*)(lb + (size_t)m * DIN + grp * 512 + c) = (u32x4){pack2(a[0], a[1]), pack2(a[2], a[3]), pack2(b2[0], b2[1]), pack2(b2[2], b2[3])}; \
      } \
      __builtin_amdgcn_sched_barrier(0); \
    } }
  for (int jp = 0; jp < 4; jp += 2) {
    LORA_STEP(jp, 0);
    LORA_STEP(jp + 1, 32768);
  }
}

__device__ void phase3(const Params& p, char* smem, int mask = 3) {
  const int n1 = 384, n2 = 256, np = T_ALL / 16, nc = 256;
  for (int item = blockIdx.x; item < n1 + n2 + np + nc; item += gridDim.x) {
    if (item < n1) { if (mask & 1) lora_item(p, item, smem); }
    else if (item < n1 + n2) { if (mask & 1) { const int t2 = item - n1; lora_tile(p, (t2 >> 2) * 20 + 16 + (t2 & 3), smem); } }
    else if (item < n1 + n2 + np) { if (mask & 2) prep_item(p, item - n1 - n2); }
    else { if (mask & 2) cache_item(p, item - n1 - n2 - np); }
  }
}

struct ScanOps { f32x4 kk[2], w[2], b[2], kd[2], r[2]; float v; };
__device__ __forceinline__ void scan_load_ops(ScanOps& o, const float* tk, int kq, int row) {
  const float* q = tk + kq * 8;
  o.kk[0] = *(const f32x4*)(q);       o.kk[1] = *(const f32x4*)(q + 4);
  o.w[0]  = *(const f32x4*)(q + 64);  o.w[1]  = *(const f32x4*)(q + 68);
  o.b[0]  = *(const f32x4*)(q + 128); o.b[1]  = *(const f32x4*)(q + 132);
  o.kd[0] = *(const f32x4*)(q + 192); o.kd[1] = *(const f32x4*)(q + 196);
  o.r[0]  = *(const f32x4*)(q + 256); o.r[1]  = *(const f32x4*)(q + 260);
  o.v = tk[320 + row];
}
__device__ __forceinline__ float oct_sum(float x) {
  x += __int_as_float(__builtin_amdgcn_mov_dpp(__float_as_int(x), 0xB1, 0xF, 0xF, true));
  x += __int_as_float(__builtin_amdgcn_mov_dpp(__float_as_int(x), 0x4E, 0xF, 0xF, true));
  x += __int_as_float(__builtin_amdgcn_mov_dpp(__float_as_int(x), 0x141, 0xF, 0xF, true));
  return x;
}
__device__ __forceinline__ float scan_step(float (&S)[8], const ScanOps& o) {
  float s0 = S[0] * o.kk[0][0], s1 = S[1] * o.kk[0][1], s2 = S[2] * o.kk[0][2], s3 = S[3] * o.kk[0][3];
  s0 += S[4] * o.kk[1][0]; s1 += S[5] * o.kk[1][1]; s2 += S[6] * o.kk[1][2]; s3 += S[7] * o.kk[1][3];
  const float sa = -oct_sum((s0 + s1) + (s2 + s3));
  float y0 = 0.f, y1 = 0.f, y2 = 0.f, y3 = 0.f;
#pragma unroll
  for (int q = 0; q < 2; ++q) {
    S[q * 4 + 0] = S[q * 4 + 0] * o.w[q][0] + (sa * o.b[q][0] + o.v * o.kd[q][0]);
    S[q * 4 + 1] = S[q * 4 + 1] * o.w[q][1] + (sa * o.b[q][1] + o.v * o.kd[q][1]);
    S[q * 4 + 2] = S[q * 4 + 2] * o.w[q][2] + (sa * o.b[q][2] + o.v * o.kd[q][2]);
    S[q * 4 + 3] = S[q * 4 + 3] * o.w[q][3] + (sa * o.b[q][3] + o.v * o.kd[q][3]);
    y0 += S[q * 4 + 0] * o.r[q][0]; y1 += S[q * 4 + 1] * o.r[q][1];
    y2 += S[q * 4 + 2] * o.r[q][2]; y3 += S[q * 4 + 3] * o.r[q][3];
  }
  return oct_sum((y0 + y1) + (y2 + y3));
}

__device__ void scan_chain(const Params& p, int item, char* smem) {
  const int tid = threadIdx.x, lane = tid & 63, wave = tid >> 6;
  const int half = item & 1, chain = item >> 1;
  int b, h, d, L, tb; bool lat;
  if (chain < 128) { lat = true; b = chain >> 4; h = (chain >> 1) & 7; d = chain & 1; L = 1024; tb = T_CTX + b * 1024; }
  else { const int c2 = chain - 128; lat = false; b = c2 >> 4; h = (c2 >> 1) & 7; d = c2 & 1; L = 256; tb = b * 256; }
  const int row = half * 32 + wave * 8 + (lane >> 3), kq = lane & 7;
  float S[8];
  if (lat) {
    const float* sp = p.state_rwkv + ((((size_t)b * 2 + d) * 8 + h) * 64 + row) * 64 + kq * 8;
    const f32x4 v0 = *(const f32x4*)sp, v1 = *(const f32x4*)(sp + 4);
    S[0] = v0[0]; S[1] = v0[1]; S[2] = v0[2]; S[3] = v0[3]; S[4] = v1[0]; S[5] = v1[1]; S[6] = v1[2]; S[7] = v1[3];
  } else {
#pragma unroll
    for (int j = 0; j < 8; ++j) S[j] = 0.f;
  }
  float* buf = (float*)smem;
  const bf16_t* pb = (const bf16_t*)(p.ws + WS_PB);
  const bf16_t* lb = (const bf16_t*)(p.ws + WS_LB);
  float* yd = (float*)(p.ws + WS_YD) + (size_t)d * T_ALL * 512;
  const int c = h * 64 + lane;
  const float kkc = p.k_k[c], kac = p.k_a[c];
  unsigned rr[4], rk[4], rv[4], rw[4], ra[4];
  const int nch = L >> 4;
#define SCAN_LOAD(CH) { _Pragma("unroll") for (int i = 0; i < 4; ++i) { const int s_ = (CH) * 16 + wave + 4 * i; const int pos_ = d ? (L - 1 - s_) : s_; \
    const size_t t_ = (size_t)(tb + pos_) * DIN; rr[i] = pb[t_ + c]; rk[i] = pb[t_ + 512 + c]; rv[i] = pb[t_ + 1024 + c]; \
    rw[i] = lb[t_ + d * 512 + c]; ra[i] = lb[t_ + 1024 + d * 512 + c]; } }
#define SCAN_STAGE(BI) { _Pragma("unroll") for (int i = 0; i < 4; ++i) { const int slot_ = wave + 4 * i; \
    const float r_ = bf2f(rr[i]), k_ = bf2f(rk[i]), v_ = bf2f(rv[i]), w_ = bf2f(rw[i]), a_ = bf2f(ra[i]); \
    const float kkr_ = k_ * kkc; const float ss_ = wave_sum(kkr_ * kkr_); const float kk_ = kkr_ * rsqrtf(ss_ + 1e-12f); \
    const float kd_ = k_ * (1.f + (a_ - 1.f) * kac); float* o_ = buf + (((BI) * 16 + slot_) * 6) * 64 + lane; \
    o_[0] = kk_; o_[64] = w_; o_[128] = kk_ * a_; o_[192] = kd_; o_[256] = r_; o_[320] = v_; } }
  SCAN_LOAD(0);
  SCAN_STAGE(0);
  __syncthreads();
  if (nch > 1) SCAN_LOAD(1);
  float* ybase = yd + (size_t)tb * 512 + h * 64 + row;
  for (int ch = 0; ch < nch; ++ch) {
    const float* cb = buf + (ch & 1) * (16 * 6 * 64);
    ScanOps oa, ob;
    scan_load_ops(oa, cb, kq, row);
#pragma unroll
    for (int s = 0; s < 16; s += 2) {
      scan_load_ops(ob, cb + (s + 1) * 384, kq, row);
      const float ya = scan_step(S, oa);
      if (s + 2 < 16) scan_load_ops(oa, cb + (s + 2) * 384, kq, row);
      const float yb = scan_step(S, ob);
      const int sg = ch * 16 + s;
      const int pa = d ? (L - 1 - sg) : sg, pbb = d ? (L - 2 - sg) : (sg + 1);
      if (kq == 0) { ybase[(size_t)pa * 512] = ya; ybase[(size_t)pbb * 512] = yb; }
    }
    if (ch + 1 < nch) SCAN_STAGE((ch + 1) & 1);
    __syncthreads();
    if (ch + 2 < nch) SCAN_LOAD(ch + 2);
  }
  if (!lat) {
    float* so = p.out + OUT_ST + ((((size_t)b * 2 + d) * 8 + h) * 64 + row) * 64 + kq * 8;
    *(f32x4*)so = (f32x4){S[0], S[1], S[2], S[3]};
    *(f32x4*)(so + 4) = (f32x4){S[4], S[5], S[6], S[7]};
  }
  __syncthreads();
}

__device__ __forceinline__ float row16_sum(float x) {
  x += __int_as_float(__builtin_amdgcn_mov_dpp(__float_as_int(x), 0xB1, 0xF, 0xF, true));
  x += __int_as_float(__builtin_amdgcn_mov_dpp(__float_as_int(x), 0x4E, 0xF, 0xF, true));
  x += __int_as_float(__builtin_amdgcn_mov_dpp(__float_as_int(x), 0x141, 0xF, 0xF, true));
  x += __int_as_float(__builtin_amdgcn_mov_dpp(__float_as_int(x), 0x140, 0xF, 0xF, true));
  return x;
}
__device__ __forceinline__ bf16x8 mk8(unsigned a, unsigned b, unsigned c, unsigned d) {
  union { u32x4 u; bf16x8 v; } cv;
  cv.u = (u32x4){a, b, c, d};
  return cv.v;
}
#define DPP_F(X, CTRL) __int_as_float(__builtin_amdgcn_mov_dpp(__float_as_int(X), CTRL, 0xF, 0xF, true))
#define DPP_SHR1(X, N) __int_as_float(__builtin_amdgcn_update_dpp(0x3f800000, __float_as_int(X), 0x110 + (N), 0xF, 0xF, false))
__device__ void scan_chunked(const Params& p, int chain, char* smem) {
  const int tid = threadIdx.x, lane = tid & 63, l15 = lane & 15, q4 = lane >> 4;
  const int wave = __builtin_amdgcn_readfirstlane(tid >> 6);
  int b, h, d, L, tb; bool lat;
  if (chain < 128) { lat = true; b = chain >> 4; h = (chain >> 1) & 7; d = chain & 1; L = 1024; tb = T_CTX + b * 1024; }
  else { const int c2 = chain - 128; lat = false; b = c2 >> 4; h = (c2 >> 1) & 7; d = c2 & 1; L = 256; tb = b * 256; }
  __syncthreads();
  for (int i = tid; i < 512; i += 256) {
    ((bf16_t*)(smem + 14592))[i] = 0; ((bf16_t*)(smem + 16640))[i] = 0;
    ((bf16_t*)(smem + 17664 + 14592))[i] = 0; ((bf16_t*)(smem + 17664 + 16640))[i] = 0;
  }
  const int val = wave * 16 + l15;
  f32x4 st[4];
  if (lat) {
    const float* sp = p.state_rwkv + ((((size_t)b * 2 + d) * 8 + h) * 64 + val) * 64 + q4 * 4;
#pragma unroll
    for (int mb = 0; mb < 4; ++mb) st[mb] = *(const f32x4*)(sp + mb * 16);
  } else {
#pragma unroll
    for (int mb = 0; mb < 4; ++mb) st[mb] = (f32x4){0.f, 0.f, 0.f, 0.f};
  }
  const int te = tid & 15, cg = tid >> 4, c0 = cg * 4;
  const f32x4 kkc = *(const f32x4*)(p.k_k + h * 64 + c0), kac = *(const f32x4*)(p.k_a + h * 64 + c0);
  const bf16_t* pb = (const bf16_t*)(p.ws + WS_PB);
  const bf16_t* lb = (const bf16_t*)(p.ws + WS_LB);
  const float* rnp = (const float*)(p.ws + WS_RN);
  bf16_t* yd = (bf16_t*)(p.ws + WS_YD) + (size_t)d * T_ALL * 512;
  const int g_chunk = (cg >> 3) * 4 + (cg & 3), g_half = ((cg >> 2) & 1) * 8;
  const int g_off = te * 128 + ((g_chunk ^ (te & 7)) << 4) + g_half;
  const int m_slot = ((te >> 2) * 8 + (te & 3)) * 2;
  uint2 rr[4], rk[4], rv[4], rw[4], ra[4];
  float rn[4];
  const int nch = L >> 4;
#define CS_LOAD(SL, CH) { const int s_ = (CH) * 16 + te; const int pos_ = d ? (L - 1 - s_) : s_; const size_t t_ = (size_t)(tb + pos_) * DIN + h * 64 + c0; \
    rr[SL] = *(const uint2*)(pb + t_); rk[SL] = *(const uint2*)(pb + t_ + 512); rv[SL] = *(const uint2*)(pb + t_ + 1024); \
    rw[SL] = *(const uint2*)(lb + t_ + d * 512); ra[SL] = *(const uint2*)(lb + t_ + 1024 + d * 512); rn[SL] = rnp[(size_t)(tb + pos_) * 8 + h]; }
  CS_LOAD(0, 0); CS_LOAD(1, 1); CS_LOAD(2, 2); CS_LOAD(3, 3);
  __syncthreads();
  for (int ch4 = 0; ch4 < nch; ch4 += 4) {
#pragma unroll
  for (int sl = 0; sl < 4; ++sl) {
    const int ch = ch4 + sl;
    char* bufp = smem + (sl & 1) * 17664;
    char* G1 = bufp; char* HH = bufp + 4096; char* M3 = bufp + 8192; char* VT = bufp + 12288;
    float* GC = (float*)(bufp + 14336); char* MB = bufp + 14592; char* M2 = bufp + 15616; char* ML = bufp + 16640;
    {
      const float r4[4] = {bflo(rr[sl].x), bfhi(rr[sl].x), bflo(rr[sl].y), bfhi(rr[sl].y)};
      const float k4[4] = {bflo(rk[sl].x), bfhi(rk[sl].x), bflo(rk[sl].y), bfhi(rk[sl].y)};
      const float w4[4] = {bflo(rw[sl].x), bfhi(rw[sl].x), bflo(rw[sl].y), bfhi(rw[sl].y)};
      const float a4[4] = {bflo(ra[sl].x), bfhi(ra[sl].x), bflo(ra[sl].y), bfhi(ra[sl].y)};
      const uint2 vraw = rv[sl];
      const float rinv = rn[sl];
      float kap[4], rh[4], bb[4], kb[4], bh[4], k2[4], gcv[4];
#pragma unroll
      for (int e = 0; e < 4; ++e) {
        const float kk = k4[e] * kkc[e] * rinv;
        const float kd = k4[e] * (1.f + (a4[e] - 1.f) * kac[e]);
        const float be = kk * a4[e];
        float g = w4[e];
        g *= DPP_SHR1(g, 1); g *= DPP_SHR1(g, 2); g *= DPP_SHR1(g, 4); g *= DPP_SHR1(g, 8);
        const float gm1 = DPP_SHR1(g, 1);
        float tot = w4[e];
        tot *= DPP_F(tot, 0xB1); tot *= DPP_F(tot, 0x4E); tot *= DPP_F(tot, 0x141); tot *= DPP_F(tot, 0x140);
        const float ib = __builtin_amdgcn_rcpf(g);
        kap[e] = kk * gm1; rh[e] = r4[e] * g;
        bb[e] = be * ib; kb[e] = kd * ib;
        bh[e] = bb[e] * tot; k2[e] = kb[e] * tot; gcv[e] = tot;
      }
      *(uint2*)(G1 + g_off) = make_uint2(pack2(kap[0], kap[1]), pack2(kap[2], kap[3]));
      *(uint2*)(G1 + 2048 + g_off) = make_uint2(pack2(rh[0], rh[1]), pack2(rh[2], rh[3]));
      *(uint2*)(HH + g_off) = make_uint2(pack2(bb[0], bb[1]), pack2(bb[2], bb[3]));
      *(uint2*)(HH + 2048 + g_off) = make_uint2(pack2(kb[0], kb[1]), pack2(kb[2], kb[3]));
#pragma unroll
      for (int e = 0; e < 4; ++e) {
        const unsigned pm = pack2(-bh[e], k2[e]);
        *(bf16_t*)(M3 + (c0 + e) * 64 + m_slot) = (bf16_t)(pm & 0xffffu);
        *(bf16_t*)(M3 + (c0 + e) * 64 + m_slot + 8) = (bf16_t)(pm >> 16);
      }
      *(bf16_t*)(VT + (c0 + 0) * 32 + te * 2) = (bf16_t)(vraw.x & 0xffffu);
      *(bf16_t*)(VT + (c0 + 1) * 32 + te * 2) = (bf16_t)(vraw.x >> 16);
      *(bf16_t*)(VT + (c0 + 2) * 32 + te * 2) = (bf16_t)(vraw.y & 0xffffu);
      *(bf16_t*)(VT + (c0 + 3) * 32 + te * 2) = (bf16_t)(vraw.y >> 16);
      if (te == 15) *(f32x4*)(GC + c0) = (f32x4){gcv[0], gcv[1], gcv[2], gcv[3]};
    }
    __syncthreads();
    if (ch + 4 < nch) CS_LOAD(sl, ch + 4);
    {
      const int gi = wave >> 1, hi = wave & 1;
      f32x4 dacc = (f32x4){0.f, 0.f, 0.f, 0.f};
#pragma unroll
      for (int s2 = 0; s2 < 2; ++s2) {
        const int sw = ((s2 * 4 + q4) ^ (l15 & 7)) << 4;
        const bf16x8 af = *(const bf16x8*)(G1 + (gi * 16 + l15) * 128 + sw);
        const bf16x8 bv = *(const bf16x8*)(HH + (hi * 16 + l15) * 128 + sw);
        dacc = __builtin_amdgcn_mfma_f32_16x16x32_bf16(af, bv, dacc, 0, 0, 0);
      }
      const int sl2 = ((l15 >> 2) * 8 + (l15 & 3)) * 2;
      if (wave == 0) {
        float li[16];
#pragma unroll
        for (int t = 0; t < 16; ++t) {
          float v = (l15 == t) ? 1.f : 0.f;
#pragma unroll
          for (int i = 0; i < t; ++i) {
            const float a_ti = __int_as_float(__builtin_amdgcn_readlane(__float_as_int(dacc[t & 3]), (t >> 2) * 16 + i));
            v -= a_ti * li[i];
          }
          li[t] = v;
          __builtin_amdgcn_sched_barrier(0);
        }
#pragma unroll
        for (int j = 0; j < 4; ++j) {
          float lv = (q4 == 0) ? li[j] : (q4 == 1) ? li[4 + j] : (q4 == 2) ? li[8 + j] : li[12 + j];
          const unsigned pm = pack2(lv, 0.f);
          *(bf16_t*)(ML + (q4 * 4 + j) * 64 + sl2) = (bf16_t)(pm & 0xffffu);
        }
      } else {
#pragma unroll
        for (int j = 0; j < 4; ++j) {
          const int t = q4 * 4 + j, i = l15;
          float xv = dacc[j];
          if (wave == 1) xv = (i < t) ? xv : 0.f;
          else if (wave == 2) xv = (i <= t) ? -xv : 0.f;
          else xv = (i <= t) ? xv : 0.f;
          const unsigned pm = pack2(xv, 0.f);
          char* dst = (wave == 1) ? (MB + t * 64 + sl2 + 8) : (wave == 2) ? (M2 + t * 64 + sl2) : (M2 + t * 64 + sl2 + 8);
          *(bf16_t*)dst = (bf16_t)(pm & 0xffffu);
        }
      }
    }
    f32x4 xk = (f32x4){0.f, 0.f, 0.f, 0.f}, xr = xk;
#pragma unroll
    for (int s2 = 0; s2 < 2; ++s2) {
      const bf16x8 sb = mk8(pack2(st[2 * s2][0], st[2 * s2][1]), pack2(st[2 * s2][2], st[2 * s2][3]),
                            pack2(st[2 * s2 + 1][0], st[2 * s2 + 1][1]), pack2(st[2 * s2 + 1][2], st[2 * s2 + 1][3]));
      const int sw = ((s2 * 4 + q4) ^ (l15 & 7)) << 4;
      const bf16x8 ak = *(const bf16x8*)(G1 + l15 * 128 + sw);
      const bf16x8 ar = *(const bf16x8*)(G1 + 2048 + l15 * 128 + sw);
      xk = __builtin_amdgcn_mfma_f32_16x16x32_bf16(ak, sb, xk, 0, 0, 0);
      xr = __builtin_amdgcn_mfma_f32_16x16x32_bf16(ar, sb, xr, 0, 0, 0);
    }
    __syncthreads();
    const uint2 vt = *(const uint2*)(VT + val * 32 + q4 * 8);
    const f32x4 z = __builtin_amdgcn_mfma_f32_16x16x32_bf16(*(const bf16x8*)(MB + l15 * 64 + q4 * 16), mk8(0u, 0u, vt.x, vt.y), xk, 0, 0, 0);
    const f32x4 pt = __builtin_amdgcn_mfma_f32_16x16x32_bf16(*(const bf16x8*)(ML + l15 * 64 + q4 * 16),
                                                            mk8(pack2(z[0], z[1]), pack2(z[2], z[3]), 0u, 0u), (f32x4){0.f, 0.f, 0.f, 0.f}, 0, 0, 0);
    const bf16x8 b2 = mk8(pack2(pt[0], pt[1]), pack2(pt[2], pt[3]), vt.x, vt.y);
    const f32x4 yt = __builtin_amdgcn_mfma_f32_16x16x32_bf16(*(const bf16x8*)(M2 + l15 * 64 + q4 * 16), b2, xr, 0, 0, 0);
#pragma unroll
    for (int j = 0; j < 4; ++j) {
      const int s_ = ch * 16 + q4 * 4 + j;
      const int pos = d ? (L - 1 - s_) : s_;
      yd[(size_t)(tb + pos) * 512 + h * 64 + val] = (bf16_t)f2bf(yt[j]);
    }
#pragma unroll
    for (int mb = 0; mb < 4; ++mb) {
      const f32x4 g = *(const f32x4*)(GC + mb * 16 + q4 * 4);
      st[mb] = st[mb] * g;
      st[mb] = __builtin_amdgcn_mfma_f32_16x16x32_bf16(*(const bf16x8*)(M3 + (mb * 16 + l15) * 64 + q4 * 16), b2, st[mb], 0, 0, 0);
    }
  }
  }
  if (!lat) {
    float* so = p.out + OUT_ST + ((((size_t)b * 2 + d) * 8 + h) * 64 + val) * 64 + q4 * 4;
#pragma unroll
    for (int mb = 0; mb < 4; ++mb) *(f32x4*)(so + mb * 16) = st[mb];
  }
  __syncthreads();
}

__device__ void attn_item(const Params& p, int item, char* smem) {
  const int tid = threadIdx.x, lane = tid & 63, wave = tid >> 6;
  const int l15 = lane & 15, q4 = lane >> 4;
  int b, hq, qt, Lk, qtok0; const bf16_t* kn; const bf16_t* vt;
  if (item < 512) {
    b = item >> 6; hq = (item >> 3) & 7; qt = item & 7; Lk = 1280; qtok0 = T_CTX + b * 1024 + qt * 128;
    const int kvh = hq >> 2;
    kn = (const bf16_t*)(p.ws + WS_KNL) + (size_t)(b * 2 + kvh) * 1280 * 64;
    vt = (const bf16_t*)(p.ws + WS_VTL) + (size_t)(b * 2 + kvh) * 64 * 1280;
  } else {
    const int i2 = item - 512;
    b = i2 >> 4; hq = (i2 >> 1) & 7; qt = i2 & 1; Lk = 256; qtok0 = b * 256 + qt * 128;
    const int kvh = hq >> 2;
    kn = (const bf16_t*)(p.ws + WS_KNC) + (size_t)(b * 2 + kvh) * 256 * 64;
    vt = (const bf16_t*)(p.ws + WS_VTC) + (size_t)(b * 2 + kvh) * 64 * 256;
  }
  const bf16_t* qn = (const bf16_t*)(p.ws + WS_QN);
  bf16_t* am = (bf16_t*)(p.ws + WS_HBUF);
  char* Ks = smem; char* Vs = smem + 8192;
  bf16x8 qf[2][2];
#pragma unroll
  for (int qs = 0; qs < 2; ++qs)
#pragma unroll
    for (int ks = 0; ks < 2; ++ks)
      qf[qs][ks] = *(const bf16x8*)(qn + (size_t)(qtok0 + wave * 32 + qs * 16 + l15) * 512 + hq * 64 + ks * 32 + q4 * 8);
  f32x4 o[2][4];
#pragma unroll
  for (int qs = 0; qs < 2; ++qs)
#pragma unroll
    for (int db = 0; db < 4; ++db) o[qs][db] = (f32x4){0.f, 0.f, 0.f, 0.f};
  float mrun[2] = {-1e30f, -1e30f}, lsum[2] = {0.f, 0.f};
  u32x4 rk[2], rv[2];
  const int nkt = Lk >> 6;
#pragma unroll
  for (int i = 0; i < 2; ++i) {
    const int idx = tid + 256 * i, r = idx >> 3, ch = idx & 7;
    rk[i] = *(const u32x4*)(kn + (size_t)r * 64 + ch * 8);
    rv[i] = *(const u32x4*)(vt + (size_t)r * Lk + ch * 8);
  }
  for (int kt = 0; kt < nkt; ++kt) {
    __syncthreads();
#pragma unroll
    for (int i = 0; i < 2; ++i) {
      const int idx = tid + 256 * i, r = idx >> 3, ch = idx & 7;
      *(u32x4*)(Ks + r * 128 + ((ch ^ (r & 7)) << 4)) = rk[i];
      *(u32x4*)(Vs + r * 144 + ch * 16) = rv[i];
    }
    __syncthreads();
    if (kt + 1 < nkt) {
#pragma unroll
      for (int i = 0; i < 2; ++i) {
        const int idx = tid + 256 * i, r = idx >> 3, ch = idx & 7;
        rk[i] = *(const u32x4*)(kn + (size_t)((kt + 1) * 64 + r) * 64 + ch * 8);
        rv[i] = *(const u32x4*)(vt + (size_t)r * Lk + (kt + 1) * 64 + ch * 8);
      }
    }
    f32x4 s[2][4];
#pragma unroll
    for (int qs = 0; qs < 2; ++qs)
#pragma unroll
      for (int kb = 0; kb < 4; ++kb) s[qs][kb] = (f32x4){0.f, 0.f, 0.f, 0.f};
#pragma unroll
    for (int ks = 0; ks < 2; ++ks)
#pragma unroll
      for (int kb = 0; kb < 4; ++kb) {
        const int key = kb * 16 + l15, ch = ks * 4 + q4;
        const bf16x8 kf = *(const bf16x8*)(Ks + key * 128 + ((ch ^ (key & 7)) << 4));
#pragma unroll
        for (int qs = 0; qs < 2; ++qs) s[qs][kb] = __builtin_amdgcn_mfma_f32_16x16x32_bf16(kf, qf[qs][ks], s[qs][kb], 0, 0, 0);
      }
#pragma unroll
    for (int qs = 0; qs < 2; ++qs) {
      float mx = -1e30f;
#pragma unroll
      for (int kb = 0; kb < 4; ++kb)
#pragma unroll
        for (int j = 0; j < 4; ++j) mx = fmaxf(mx, s[qs][kb][j]);
      mx = fmaxf(mx, __shfl_xor(mx, 16));
      mx = fmaxf(mx, __shfl_xor(mx, 32));
      const float mn = fmaxf(mrun[qs], mx);
      const float alpha = __builtin_amdgcn_exp2f(mrun[qs] - mn);
      mrun[qs] = mn;
      float ps = 0.f;
#pragma unroll
      for (int kb = 0; kb < 4; ++kb)
#pragma unroll
        for (int j = 0; j < 4; ++j) { const float pv = __builtin_amdgcn_exp2f(s[qs][kb][j] - mn); s[qs][kb][j] = pv; ps += pv; }
      lsum[qs] = lsum[qs] * alpha + ps;
#pragma unroll
      for (int db = 0; db < 4; ++db) o[qs][db] *= alpha;
    }
#pragma unroll
    for (int s2 = 0; s2 < 2; ++s2) {
      bf16x8 pf[2];
#pragma unroll
      for (int qs = 0; qs < 2; ++qs) {
        union { uint4 u; bf16x8 v; } cv;
        cv.u = make_uint4(pack2(s[qs][2 * s2][0], s[qs][2 * s2][1]), pack2(s[qs][2 * s2][2], s[qs][2 * s2][3]),
                          pack2(s[qs][2 * s2 + 1][0], s[qs][2 * s2 + 1][1]), pack2(s[qs][2 * s2 + 1][2], s[qs][2 * s2 + 1][3]));
        pf[qs] = cv.v;
      }
#pragma unroll
      for (int db = 0; db < 4; ++db) {
        const char* vp = Vs + (db * 16 + l15) * 144 + (s2 * 32 + q4 * 4) * 2;
        const uint2 lo = *(const uint2*)vp;
        const uint2 hi = *(const uint2*)(vp + 32);
        union { uint4 u; bf16x8 v; } cv;
        cv.u = make_uint4(lo.x, lo.y, hi.x, hi.y);
#pragma unroll
        for (int qs = 0; qs < 2; ++qs) o[qs][db] = __builtin_amdgcn_mfma_f32_16x16x32_bf16(cv.v, pf[qs], o[qs][db], 0, 0, 0);
      }
    }
  }
#pragma unroll
  for (int qs = 0; qs < 2; ++qs) {
    float l = lsum[qs];
    l += __shfl_xor(l, 16);
    l += __shfl_xor(l, 32);
    const float inv = 1.f / l;
    const size_t tok = (size_t)(qtok0 + wave * 32 + qs * 16 + l15);
#pragma unroll
    for (int db = 0; db < 4; ++db) {
      const f32x4 v = o[qs][db] * inv;
      *(uint2*)(am + tok * DM + 512 + hq * 64 + db * 16 + q4 * 4) = make_uint2(pack2(v[0], v[1]), pack2(v[2], v[3]));
    }
  }
  __syncthreads();
}

__device__ void phase4(const Params& p, char* smem, unsigned* bar, volatile LAS unsigned* qslot, int rep) {
  unsigned* q0 = &bar[XB_QUEUE + 256 * rep];
  for (;;) {
    __syncthreads();
    if (threadIdx.x == 0) *qslot = xb_add(q0, 1u);
    __syncthreads();
    const unsigned item = *qslot;
    if (item >= 384u) break;
    scan_chunked(p, (int)item, smem);
  }
  for (;;) {
    __syncthreads();
    if (threadIdx.x == 0) *qslot = xb_add(q0 + 64, 1u);
    __syncthreads();
    const unsigned item = *qslot;
    if (item >= 768u) break;
    attn_item(p, (int)item, smem);
  }
  if (rep == 0) {
    for (;;) {
      __syncthreads();
      if (threadIdx.x == 0) *qslot = xb_add(q0 + 128, 1u);
      __syncthreads();
      const unsigned item = *qslot;
      if (item >= 360u) break;
      if (item < 64u) { __syncthreads(); adaln_item(p, 32 + (int)item, -1, smem); }
      else for (int j = 0; j < 8; ++j) { __syncthreads(); transpose_item(p, 640 + ((int)item - 64) * 8 + j, smem); }
    }
  }
}

__device__ __forceinline__ float half_sum(float v) {
  v += __int_as_float(__builtin_amdgcn_mov_dpp(__float_as_int(v), 0xB1, 0xF, 0xF, true));
  v += __int_as_float(__builtin_amdgcn_mov_dpp(__float_as_int(v), 0x4E, 0xF, 0xF, true));
  v += __int_as_float(__builtin_amdgcn_mov_dpp(__float_as_int(v), 0x141, 0xF, 0xF, true));
  v += __int_as_float(__builtin_amdgcn_mov_dpp(__float_as_int(v), 0x140, 0xF, 0xF, true));
  v += __shfl_xor(v, 16);
  return v;
}
__device__ void phase5(const Params& p) {
  const int lane = threadIdx.x & 63, wave = threadIdx.x >> 6;
  const int hh = lane >> 5, l2 = (lane & 31) * 2;
  const bf16_t* pb = (const bf16_t*)(p.ws + WS_PB);
  const bf16_t* lb = (const bf16_t*)(p.ws + WS_LB);
  const bf16_t* yd0 = (const bf16_t*)(p.ws + WS_YD);
  const bf16_t* yd1 = yd0 + (size_t)T_ALL * 512;
  bf16_t* am = (bf16_t*)(p.ws + WS_HBUF);
  for (int it = blockIdx.x; it < T_ALL / 4; it += gridDim.x) {
    const int t = it * 4 + wave;
    const bf16_t* prow = pb + (size_t)t * DIN;
    const bf16_t* lrow = lb + (size_t)t * DIN;
#pragma unroll 4
    for (int hp = 0; hp < 4; ++hp) {
      const int c = (hp * 2 + hh) * 64 + l2;
      const unsigned y0 = *(const unsigned*)(yd0 + (size_t)t * 512 + c), y1 = *(const unsigned*)(yd1 + (size_t)t * 512 + c);
      const unsigned ur = *(const unsigned*)(prow + c), uk = *(const unsigned*)(prow + 512 + c), uv = *(const unsigned*)(prow + 1024 + c);
      const unsigned ua0 = *(const unsigned*)(lrow + 1024 + c), ua1 = *(const unsigned*)(lrow + 1536 + c), ug = *(const unsigned*)(lrow + 2048 + c);
      const float2 gw = *(const float2*)(p.gn_w + c), gb = *(const float2*)(p.gn_b + c), ka = *(const float2*)(p.k_a + c), rk = *(const float2*)(p.r_k + c);
      const float ya = bflo(y0) + bflo(y1), yb = bfhi(y0) + bfhi(y1);
      const float mu = half_sum(ya + yb) * (1.f / 64.f);
      const float da = ya - mu, db = yb - mu;
      const float var = half_sum(da * da + db * db) * (1.f / 64.f);
      const float rs = rsqrtf(var + 64e-5f);
      const float kdsa = bflo(uk) * (2.f + (bflo(ua0) + bflo(ua1) - 2.f) * ka.x);
      const float kdsb = bfhi(uk) * (2.f + (bfhi(ua0) + bfhi(ua1) - 2.f) * ka.y);
      const float dot = half_sum(bflo(ur) * kdsa * rk.x + bfhi(ur) * kdsb * rk.y);
      const float oa = (da * rs * gw.x + gb.x + dot * bflo(uv)) * bflo(ug);
      const float ob = (db * rs * gw.y + gb.y + dot * bfhi(uv)) * bfhi(ug);
      *(unsigned*)(am + (size_t)t * DM + c) = pack2(oa, ob);
    }
  }
}

__device__ void phase6(const Params& p, char* smem) {
  const bf16_t* A = (const bf16_t*)(p.ws + WS_HBUF);
  const bf16_t* B = (const bf16_t*)(p.ws + WS_WTOUT);
  bf16_t* mix = (bf16_t*)(p.ws + WS_MIX);
  int mt, nt;
  bool have = xcd_tile(0, 8, mt, nt), pre = false;
  for (int it = 0; have; ++it) {
    int mt2 = 0, nt2 = 0;
    const bool have2 = xcd_tile(it + 1, 8, mt2, nt2);
    const bf16_t* nA_ = have2 ? (A + (size_t)mt2 * 192 * DM) : nullptr;
    const bf16_t* nB_ = have2 ? (B + (size_t)nt2 * 128 * DM) : nullptr;
    gemm_tile(A + (size_t)mt * 192 * DM, DM, B + (size_t)nt * 128 * DM, DM, DM, smem,
              [&](int ml, int nl, f32x4 a, f32x4 b2) { *(u32x4*)(mix + (size_t)(mt * 192 + ml) * DM + nt * 128 + nl) = (u32x4){pack2(a[0], a[1]), pack2(a[2], a[3]), pack2(b2[0], b2[1]), pack2(b2[2], b2[3])}; }, pre, nA_, nB_);
    pre = have2; mt = mt2; nt = nt2; have = have2;
  }
}
__device__ void phase8(const Params& p, char* smem) {
  const bf16_t* A = (const bf16_t*)(p.ws + WS_HBUF);
  const bf16_t* B = (const bf16_t*)(p.ws + WS_WTUP);
  bf16_t* u = (bf16_t*)(p.ws + WS_U);
  int mt, nt;
  bool have = xcd_tile(0, 44, mt, nt), pre = false;
  for (int it = 0; have; ++it) {
    int mt2 = 0, nt2 = 0;
    const bool have2 = xcd_tile(it + 1, 44, mt2, nt2);
    const bf16_t* nA_ = have2 ? (A + (size_t)mt2 * 192 * DM) : nullptr;
    const bf16_t* nB_ = have2 ? (B + (size_t)nt2 * 128 * DM) : nullptr;
    gemm_tile(A + (size_t)mt * 192 * DM, DM, B + (size_t)nt * 128 * DM, DM, DM, smem,
              [&](int ml, int nl, f32x4 a, f32x4 b2) {
                *(u32x4*)(u + (size_t)(mt * 192 + ml) * DFF2 + nt * 128 + nl) = (u32x4){pack2(a[0], a[1]), pack2(a[2], a[3]), pack2(b2[0], b2[1]), pack2(b2[2], b2[3])};
              }, pre, nA_, nB_);
    pre = have2; mt = mt2; nt = nt2; have = have2;
  }
}
__device__ void phase10(const Params& p, char* smem) {
  const bf16_t* A = (const bf16_t*)(p.ws + WS_ACT);
  const bf16_t* B = (const bf16_t*)(p.ws + WS_WTDN);
  bf16_t* f = (bf16_t*)(p.ws + WS_F);
  int mt, nt;
  bool have = xcd_tile(0, 8, mt, nt), pre = false;
  for (int it = 0; have; ++it) {
    int mt2 = 0, nt2 = 0;
    const bool have2 = xcd_tile(it + 1, 8, mt2, nt2);
    const bf16_t* nA_ = have2 ? (A + (size_t)mt2 * 192 * DFF) : nullptr;
    const bf16_t* nB_ = have2 ? (B + (size_t)nt2 * 128 * DFF) : nullptr;
    gemm_tile(A + (size_t)mt * 192 * DFF, DFF, B + (size_t)nt * 128 * DFF, DFF, DFF, smem,
              [&](int ml, int nl, f32x4 a, f32x4 b2) { *(u32x4*)(f + (size_t)(mt * 192 + ml) * DM + nt * 128 + nl) = (u32x4){pack2(a[0], a[1]), pack2(a[2], a[3]), pack2(b2[0], b2[1]), pack2(b2[2], b2[3])}; }, pre, nA_, nB_);
    pre = have2; mt = mt2; nt = nt2; have = have2;
  }
}

__device__ void phase7(const Params& p) {
  const int lane = threadIdx.x & 63, wave = threadIdx.x >> 6;
  const float* mod = (const float*)(p.ws + WS_MOD);
  const bf16_t* mix = (const bf16_t*)(p.ws + WS_MIX);
  bf16_t* hb = (bf16_t*)(p.ws + WS_HBUF);
  for (int it = blockIdx.x; it < T_ALL / 4; it += gridDim.x) {
    const int t = it * 4 + wave;
    const float* x = xrow(p, t);
    const float* md = mod + modrow(t) * 6144;
    float4 v[4];
    float ss = 0.f;
#pragma unroll
    for (int i = 0; i < 4; ++i) {
      { const uint2 u_ = *(const uint2*)(mix + (size_t)t * DM + (i * 64 + lane) * 4); v[i] = make_float4(bflo(u_.x), bfhi(u_.x), bflo(u_.y), bfhi(u_.y)); }
      ss += v[i].x * v[i].x + v[i].y * v[i].y + v[i].z * v[i].z + v[i].w * v[i].w;
    }
    ss = wave_sum(ss);
    const float rstd = rsqrtf(ss * (1.f / 1024.f) + 1e-6f);
    float ss2 = 0.f;
#pragma unroll
    for (int i = 0; i < 4; ++i) {
      const int c = (i * 64 + lane) * 4;
      const float4 xv = *(const float4*)(x + c);
      const float4 g = *(const float4*)(p.norm_mix_post + c);
      const float4 gt = *(const float4*)(md + 2048 + c);
      v[i].x = xv.x + gt.x * (v[i].x * rstd * g.x);
      v[i].y = xv.y + gt.y * (v[i].y * rstd * g.y);
      v[i].z = xv.z + gt.z * (v[i].z * rstd * g.z);
      v[i].w = xv.w + gt.w * (v[i].w * rstd * g.w);
      *(float4*)(p.out + (size_t)t * DM + c) = v[i];
      ss2 += v[i].x * v[i].x + v[i].y * v[i].y + v[i].z * v[i].z + v[i].w * v[i].w;
    }
    ss2 = wave_sum(ss2);
    const float rstd2 = rsqrtf(ss2 * (1.f / 1024.f) + 1e-6f);
#pragma unroll
    for (int i = 0; i < 4; ++i) {
      const int c = (i * 64 + lane) * 4;
      const float4 g = *(const float4*)(p.norm_ffn_pre + c);
      const float4 sh = *(const float4*)(md + 3072 + c);
      const float4 sc = *(const float4*)(md + 4096 + c);
      const float o0 = v[i].x * rstd2 * g.x * (1.f + sc.x) + sh.x;
      const float o1 = v[i].y * rstd2 * g.y * (1.f + sc.y) + sh.y;
      const float o2 = v[i].z * rstd2 * g.z * (1.f + sc.z) + sh.z;
      const float o3 = v[i].w * rstd2 * g.w * (1.f + sc.w) + sh.w;
      *(uint2*)(hb + (size_t)t * DM + c) = make_uint2(pack2(o0, o1), pack2(o2, o3));
    }
  }
}

__device__ void phase9(const Params& p) {
  const bf16_t* u = (const bf16_t*)(p.ws + WS_U);
  bf16_t* act = (bf16_t*)(p.ws + WS_ACT);
  const int cgi = threadIdx.x & 31, tsub = threadIdx.x >> 5;
  for (int it = blockIdx.x; it < 11 * 192; it += gridDim.x) {
    const int cb = it % 11, tt = it / 11;
    const int cc = (cb * 32 + cgi) * 8;
    const int t0 = tt * 64 + tsub * 8;
    const int L = t0 < T_CTX ? 256 : 1024;
    const int pos0 = t0 < T_CTX ? (t0 & 255) : ((t0 - T_CTX) & 1023);
    float wg[3][8], wv[3][8], bg[8], bv[8];
#pragma unroll
    for (int j = 0; j < 3; ++j) {
      const float4 a0 = *(const float4*)(p.conv_w + j * DFF2 + cc), a1 = *(const float4*)(p.conv_w + j * DFF2 + cc + 4);
      const float4 c0 = *(const float4*)(p.conv_w + j * DFF2 + DFF + cc), c1 = *(const float4*)(p.conv_w + j * DFF2 + DFF + cc + 4);
      wg[j][0] = a0.x; wg[j][1] = a0.y; wg[j][2] = a0.z; wg[j][3] = a0.w; wg[j][4] = a1.x; wg[j][5] = a1.y; wg[j][6] = a1.z; wg[j][7] = a1.w;
      wv[j][0] = c0.x; wv[j][1] = c0.y; wv[j][2] = c0.z; wv[j][3] = c0.w; wv[j][4] = c1.x; wv[j][5] = c1.y; wv[j][6] = c1.z; wv[j][7] = c1.w;
    }
    {
      const float4 a0 = *(const float4*)(p.conv_b + cc), a1 = *(const float4*)(p.conv_b + cc + 4);
      const float4 c0 = *(const float4*)(p.conv_b + DFF + cc), c1 = *(const float4*)(p.conv_b + DFF + cc + 4);
      bg[0] = a0.x; bg[1] = a0.y; bg[2] = a0.z; bg[3] = a0.w; bg[4] = a1.x; bg[5] = a1.y; bg[6] = a1.z; bg[7] = a1.w;
      bv[0] = c0.x; bv[1] = c0.y; bv[2] = c0.z; bv[3] = c0.w; bv[4] = c1.x; bv[5] = c1.y; bv[6] = c1.z; bv[7] = c1.w;
    }
    const bf16_t* ur = u + (size_t)t0 * DFF2 + cc;
    const u32x4 z = (u32x4){0u, 0u, 0u, 0u};
    u32x4 g0 = (pos0 > 0) ? *(const u32x4*)(ur - DFF2) : z;
    u32x4 v0 = (pos0 > 0) ? *(const u32x4*)(ur - DFF2 + DFF) : z;
    u32x4 g1 = *(const u32x4*)(ur);
    u32x4 v1 = *(const u32x4*)(ur + DFF);
#pragma unroll 4
    for (int i = 0; i < 8; ++i) {
      const bool hp = (pos0 + i) < L - 1;
      const u32x4 g2 = hp ? *(const u32x4*)(ur + (size_t)(i + 1) * DFF2) : z;
      const u32x4 v2 = hp ? *(const u32x4*)(ur + (size_t)(i + 1) * DFF2 + DFF) : z;
      unsigned o[4];
#pragma unroll
      for (int e2 = 0; e2 < 4; ++e2) {
        const float ga = bg[2 * e2] + wg[0][2 * e2] * bflo(g0[e2]) + wg[1][2 * e2] * bflo(g1[e2]) + wg[2][2 * e2] * bflo(g2[e2]);
        const float gb = bg[2 * e2 + 1] + wg[0][2 * e2 + 1] * bfhi(g0[e2]) + wg[1][2 * e2 + 1] * bfhi(g1[e2]) + wg[2][2 * e2 + 1] * bfhi(g2[e2]);
        const float va = bv[2 * e2] + wv[0][2 * e2] * bflo(v0[e2]) + wv[1][2 * e2] * bflo(v1[e2]) + wv[2][2 * e2] * bflo(v2[e2]);
        const float vb = bv[2 * e2 + 1] + wv[0][2 * e2 + 1] * bfhi(v0[e2]) + wv[1][2 * e2 + 1] * bfhi(v1[e2]) + wv[2][2 * e2 + 1] * bfhi(v2[e2]);
        o[e2] = pack2(ga * sigmoidf_(ga) * va, gb * sigmoidf_(gb) * vb);
      }
      *(u32x4*)(act + (size_t)(t0 + i) * DFF + cc) = (u32x4){o[0], o[1], o[2], o[3]};
      g0 = g1; g1 = g2; v0 = v1; v1 = v2;
    }
  }
}

__device__ void phase11(const Params& p) {
  const int lane = threadIdx.x & 63, wave = threadIdx.x >> 6;
  const float* mod = (const float*)(p.ws + WS_MOD);
  const bf16_t* f = (const bf16_t*)(p.ws + WS_F);
  for (int it = blockIdx.x; it < T_ALL / 4; it += gridDim.x) {
    const int t = it * 4 + wave;
    const float* md = mod + modrow(t) * 6144;
    float4 v[4];
    float ss = 0.f;
#pragma unroll
    for (int i = 0; i < 4; ++i) {
      { const uint2 u_ = *(const uint2*)(f + (size_t)t * DM + (i * 64 + lane) * 4); v[i] = make_float4(bflo(u_.x), bfhi(u_.x), bflo(u_.y), bfhi(u_.y)); }
      ss += v[i].x * v[i].x + v[i].y * v[i].y + v[i].z * v[i].z + v[i].w * v[i].w;
    }
    ss = wave_sum(ss);
    const float rstd = rsqrtf(ss * (1.f / 1024.f) + 1e-6f);
#pragma unroll
    for (int i = 0; i < 4; ++i) {
      const int c = (i * 64 + lane) * 4;
      float4 xv = *(const float4*)(p.out + (size_t)t * DM + c);
      const float4 g = *(const float4*)(p.norm_ffn_post + c);
      const float4 gt = *(const float4*)(md + 5120 + c);
      xv.x += gt.x * (v[i].x * rstd * g.x);
      xv.y += gt.y * (v[i].y * rstd * g.y);
      xv.z += gt.z * (v[i].z * rstd * g.z);
      xv.w += gt.w * (v[i].w * rstd * g.w);
      *(float4*)(p.out + (size_t)t * DM + c) = xv;
    }
  }
}

#define SMEM_BYTES 81920
__global__ void __launch_bounds__(256, 2) hybrid_fwd(Params p) {
  __shared__ __attribute__((aligned(16))) char smem[SMEM_BYTES];
  __syncthreads();
  unsigned* bar = (unsigned*)(p.ws + WS_BAR);
  XcdBarrier xb = xcd_barrier_post(bar);
  volatile LAS unsigned* qslot = (volatile LAS unsigned*)(smem + SMEM_BYTES - 16);

  const int zr = (int)xb_ld(&bar[8]);
#define RUNPH(N, CALL) { CALL; if (REPP == (N)) { xcd_barrier(xb); for (int r_ = 0; r_ < 1 + zr; ++r_) { CALL; } } }
  RUNPH(0, phase0(p, smem));
  xcd_barrier(xb);
  RUNPH(1, phase1(p));
  xcd_barrier(xb);
  RUNPH(2, phase2(p, smem));
  xcd_barrier(xb);
  phase3(p, smem);
  if (REPP == 31) { xcd_barrier(xb); phase3(p, smem, 1 + zr); }
  if (REPP == 32) { xcd_barrier(xb); phase3(p, smem, 2 + zr); }
  xcd_barrier(xb);
  phase4(p, smem, bar, qslot, 0);
  if (REPP == 4) { xcd_barrier(xb); phase4(p, smem, bar, qslot, 1); }
  xcd_barrier(xb);
  RUNPH(5, phase5(p));
  xcd_barrier(xb);
  RUNPH(6, phase6(p, smem));
  xcd_barrier(xb);
  RUNPH(7, phase7(p));
  xcd_barrier(xb);
  RUNPH(8, phase8(p, smem));
  xcd_barrier(xb);
  RUNPH(9, phase9(p));
  xcd_barrier(xb);
  RUNPH(10, phase10(p, smem));
  xcd_barrier(xb);
  phase11(p);
}

extern "C" void kernel_launch(void* const* d_in, const int* in_sizes, int n_in, void* d_out, int out_size,
                              void* d_ws, size_t ws_size, hipStream_t stream) {
  static int grid_blocks = 0;
  if (!grid_blocks) {
    int dev = 0, cus = 0, per_cu = 0;
    hipGetDevice(&dev);
    hipDeviceGetAttribute(&cus, hipDeviceAttributeMultiprocessorCount, dev);
    hipOccupancyMaxActiveBlocksPerMultiprocessor(&per_cu, hybrid_fwd, 256, 0);
    if (per_cu > 2) per_cu = 2;
    if (per_cu < 1) per_cu = 1;
    grid_blocks = cus * per_cu;
  }
  Params p{};
  const float** pp = (const float**)&p;
  for (int i = 0; i < 31; ++i) pp[i] = (const float*)d_in[i];
  p.out = (float*)d_out;
  p.ws = (char*)d_ws;
  hipMemsetAsync(d_ws, 0, 16384, stream);
  void* args[] = {&p};
  hipError_t e = hipLaunchCooperativeKernel((void*)hybrid_fwd, dim3(grid_blocks), dim3(256), args, 0, stream);
  if (e != hipSuccess) fprintf(stderr, "cooperative launch failed: %s (grid %d)\n", hipGetErrorString(e), grid_blocks);
}
```
